# Optimizing an MI355X kernel written in HIP

```python
import math
import jax, jax.numpy as jnp
from jax import lax
import numpy as np

D_MODEL = 1024
BATCH = 8
SEQ = 4096
DEPTH = 1

HEAD_DIM = 64
SB_HEADS = 8
SB_WIDTH = SB_HEADS * HEAD_DIM
DIL_CONFIGS = ((128, 1), (512, 4), (2048, 16))
DIL_HEADS_PER_GROUP = 4
DIL_HEADS = DIL_HEADS_PER_GROUP * len(DIL_CONFIGS)
DIL_WIDTH = DIL_HEADS * HEAD_DIM
DIL_OUT_WIDTH = DIL_HEADS_PER_GROUP * HEAD_DIM
IN_SPLIT_SIZES = (SB_WIDTH, SB_WIDTH, SB_WIDTH, DIL_WIDTH, DIL_WIDTH, DIL_WIDTH, D_MODEL, D_MODEL)
IN_PROJ_WIDTH = sum(IN_SPLIT_SIZES)
IN_SPLIT_POINTS = tuple(int(v) for v in np.cumsum(IN_SPLIT_SIZES)[:-1])
Q_BLOCK = 128
N_BUCKETS = 32
MAX_DISTANCE = 2048
N_EXPERTS = 256
TOP_K = 8
N_GROUPS = 8
TOP_K_GROUPS = 4
EXPERT_DIM = 256
ROUTED_SCALE = 2.5
DISPATCH_BLOCK = 128
N_MOD = 6
EPS = 1e-6

kernel_name = 'hybrid_stickbreak_dilated_moe_block'


def rms_norm(x, g):
    xf = x.astype(jnp.float32)
    y = xf * lax.rsqrt(jnp.mean(xf * xf, axis=-1, keepdims=True) + EPS)
    return (y * g.astype(jnp.float32)).astype(x.dtype)


def swiglu(x, w_gate, w_up, w_down):
    return (jax.nn.silu(x @ w_gate) * (x @ w_up)) @ w_down


def t5_causal_bucket(dist):
    max_exact = N_BUCKETS // 2
    d = jnp.maximum(dist, 1).astype(jnp.float32)
    large = max_exact + (jnp.log(d / max_exact) / math.log(MAX_DISTANCE / max_exact)
                         * (N_BUCKETS - max_exact)).astype(jnp.int32)
    large = jnp.minimum(large, N_BUCKETS - 1)
    return jnp.where(dist < max_exact, dist, large)


def stick_breaking_attention(q, k, v):
    b, s, h, dh = q.shape
    n_blocks = s // Q_BLOCK
    scale = dh ** -0.5
    k_t = k.transpose(0, 2, 1, 3).astype(jnp.float32)
    v_t = v.transpose(0, 2, 1, 3)
    q_blocks = q.reshape(b, n_blocks, Q_BLOCK, h, dh).transpose(1, 0, 3, 2, 4)
    key_pos = jnp.arange(s)

    def one_block(args):
        qb, blk = args
        z = jnp.einsum('bhqd,bhkd->bhqk', qb.astype(jnp.float32), k_t) * scale
        q_pos = blk * Q_BLOCK + jnp.arange(Q_BLOCK)
        past = key_pos[None, :] < q_pos[:, None]
        log_keep = jnp.where(past, jax.nn.log_sigmoid(-z), 0.0)
        log_between = lax.cumsum(log_keep, axis=3, reverse=True) - log_keep
        weights = jnp.where(past, jnp.exp(jax.nn.log_sigmoid(z) + log_between), 0.0)
        return jnp.einsum('bhqk,bhkd->bhqd', weights.astype(v_t.dtype), v_t)

    out = lax.map(one_block, (q_blocks, jnp.arange(n_blocks)))
    return out.transpose(1, 0, 3, 2, 4).reshape(b, s, h * dh)


def dilated_group_attention(q, k, v, bias_table, window, dilation):
    b, s, hg, dh = q.shape
    n_sub = s // dilation
    n_blk = -(-n_sub // Q_BLOCK)
    l_pad = n_blk * Q_BLOCK
    w_sub = window // dilation
    scale = dh ** -0.5

    def to_sub(t):
        return t.reshape(b, n_sub, dilation, hg, dh).transpose(0, 2, 3, 1, 4)

    pad_q = ((0, 0), (0, 0), (0, 0), (0, l_pad - n_sub), (0, 0))
    pad_kv = ((0, 0), (0, 0), (0, 0), (Q_BLOCK, l_pad - n_sub), (0, 0))
    qb = jnp.pad(to_sub(q), pad_q).reshape(b, dilation, hg, n_blk, Q_BLOCK, dh)

    def band(t):
        tp = jnp.pad(to_sub(t), pad_kv)
        prev = tp[:, :, :, :l_pad].reshape(b, dilation, hg, n_blk, Q_BLOCK, dh)
        cur = tp[:, :, :, Q_BLOCK:].reshape(b, dilation, hg, n_blk, Q_BLOCK, dh)
        return jnp.concatenate([prev, cur], axis=4)

    kb, vb = band(k), band(v)
    qi = jnp.arange(Q_BLOCK)[:, None]
    kj = jnp.arange(2 * Q_BLOCK)[None, :]
    dist_sub = qi + Q_BLOCK - kj
    bucket = t5_causal_bucket(jnp.maximum(dist_sub, 0) * dilation)
    bias = bias_table[bucket].astype(jnp.float32).transpose(2, 0, 1)
    key_n = jnp.arange(n_blk)[:, None, None] * Q_BLOCK - Q_BLOCK + kj[None]
    valid = (dist_sub >= 0) & (dist_sub <= w_sub) & (key_n >= 0)
    logits = jnp.einsum('brhnqd,brhnkd->brhnqk', qb.astype(jnp.float32), kb.astype(jnp.float32)) * scale
    logits = jnp.where(valid, logits + bias[None, None, :, None], -jnp.inf)
    lse = jax.nn.logsumexp(logits, axis=-1)
    p = jnp.exp(logits - lse[..., None])
    o = jnp.einsum('brhnqk,brhnkd->brhnqd', p.astype(vb.dtype), vb)
    o = o.reshape(b, dilation, hg, l_pad, dh)[:, :, :, :n_sub]
    o = o.transpose(0, 3, 1, 2, 4).reshape(b, s, hg, dh)
    lse = lse.reshape(b, dilation, hg, l_pad)[:, :, :, :n_sub]
    lse = lse.transpose(0, 3, 1, 2).reshape(b, s, hg)
    return o, lse


def hybrid_mixer(h, w_in, w_branch_a, w_branch_b, w_out, rel_bias):
    b, s, _ = h.shape
    proj = h @ w_in
    sb_q, sb_k, sb_v, dq, dk, dv, gate_a, gate_b = jnp.split(proj, IN_SPLIT_POINTS, axis=-1)
    heads_a = lambda t: t.reshape(b, s, SB_HEADS, HEAD_DIM)
    out_a = stick_breaking_attention(heads_a(sb_q), heads_a(sb_k), heads_a(sb_v)) @ w_branch_a
    heads_b = lambda t: t.reshape(b, s, DIL_HEADS, HEAD_DIM)
    dq, dk, dv = heads_b(dq), heads_b(dk), heads_b(dv)
    outs, lses = [], []
    for g, (window, dilation) in enumerate(DIL_CONFIGS):
        sl = slice(g * DIL_HEADS_PER_GROUP, (g + 1) * DIL_HEADS_PER_GROUP)
        o, l = dilated_group_attention(dq[:, :, sl], dk[:, :, sl], dv[:, :, sl], rel_bias[:, sl], window, dilation)
        outs.append(o)
        lses.append(l)
    mix_w = jax.nn.softmax(jnp.stack(lses, axis=0), axis=0)
    out_b = jnp.sum(mix_w[..., None].astype(outs[0].dtype) * jnp.stack(outs, axis=0), axis=0)
    out_b = out_b.reshape(b, s, DIL_OUT_WIDTH) @ w_branch_b
    merged = jax.nn.sigmoid(gate_a) * out_a + jax.nn.sigmoid(gate_b) * out_b
    return merged @ w_out


def moe_ffn(h, w_router, router_bias, w_exp_gate, w_exp_up, w_exp_down, w_sh_gate, w_sh_up, w_sh_down):
    b, s, d = h.shape
    n_tok = b * s
    hf = h.reshape(n_tok, d)
    shared = swiglu(hf, w_sh_gate, w_sh_up, w_sh_down)
    scores = jax.nn.sigmoid((hf @ w_router).astype(jnp.float32))
    sel = scores + router_bias.astype(jnp.float32)
    per_group = N_EXPERTS // N_GROUPS
    group_score = lax.top_k(sel.reshape(n_tok, N_GROUPS, per_group), 2)[0].sum(-1)
    _, top_groups = lax.top_k(group_score, TOP_K_GROUPS)
    group_mask = jax.nn.one_hot(top_groups, N_GROUPS, dtype=jnp.float32).sum(1)
    sel = jnp.where(jnp.repeat(group_mask, per_group, axis=1) > 0, sel, -jnp.inf)
    _, expert_idx = lax.top_k(sel, TOP_K)
    gate_w = jnp.take_along_axis(scores, expert_idx, axis=1)
    gate_w = gate_w / jnp.sum(gate_w, axis=-1, keepdims=True) * ROUTED_SCALE
    n_slot = n_tok * TOP_K
    e_flat = expert_idx.reshape(-1)
    tok_flat = jnp.repeat(jnp.arange(n_tok, dtype=jnp.int32), TOP_K)
    w_flat = gate_w.reshape(-1)
    order = jnp.argsort(e_flat)
    e_sorted = e_flat[order]
    counts = jnp.zeros((N_EXPERTS,), jnp.int32).at[e_flat].add(1)
    starts = jnp.cumsum(counts) - counts
    padded = (counts + DISPATCH_BLOCK - 1) // DISPATCH_BLOCK * DISPATCH_BLOCK
    p_ends = jnp.cumsum(padded)
    p_starts = p_ends - padded
    dest = p_starts[e_sorted] + (jnp.arange(n_slot, dtype=jnp.int32) - starts[e_sorted])
    n_blk = -(-n_slot // DISPATCH_BLOCK) + N_EXPERTS
    n_pad = n_blk * DISPATCH_BLOCK
    slot_tok = jnp.full((n_pad,), n_tok, jnp.int32).at[dest].set(tok_flat[order])
    slot_w = jnp.zeros((n_pad,), jnp.float32).at[dest].set(w_flat[order])
    blk_expert = jnp.minimum(jnp.searchsorted(p_ends, jnp.arange(n_blk, dtype=jnp.int32) * DISPATCH_BLOCK,
                                              side='right'), N_EXPERTS - 1)
    h_pad = jnp.concatenate([hf, jnp.zeros((1, d), hf.dtype)], axis=0)

    def expert_block(args):
        tok, wt, e = args
        yb = swiglu(h_pad[tok], w_exp_gate[e], w_exp_up[e], w_exp_down[e])
        return yb * wt[:, None].astype(yb.dtype)

    y = lax.map(expert_block, (slot_tok.reshape(n_blk, DISPATCH_BLOCK),
                               slot_w.reshape(n_blk, DISPATCH_BLOCK), blk_expert))
    routed = jax.ops.segment_sum(y.reshape(n_pad, d), slot_tok, num_segments=n_tok + 1)[:n_tok]
    return (shared + routed).reshape(b, s, d)


def setup_inputs(seed: int = 0) -> dict:
    key = jax.random.key(seed)
    ks = jax.random.split(key, 21)

    def normal(k, shape, scale):
        return jax.random.normal(k, shape, jnp.float32) * scale

    L = DEPTH
    return {
        'x': normal(ks[0], (BATCH, SEQ, D_MODEL), 1.0),
        'c': normal(ks[1], (BATCH, D_MODEL), 1.0),
        'rel_bias': normal(ks[2], (N_BUCKETS, DIL_HEADS), 0.5),
        'w_ada': normal(ks[3], (L, D_MODEL, N_MOD * D_MODEL), 0.5 * D_MODEL ** -0.5),
        'b_ada': normal(ks[4], (L, N_MOD * D_MODEL), 0.02),
        'g_pre_mix': 1.0 + normal(ks[5], (L, D_MODEL), 0.05),
        'w_in': normal(ks[6], (L, D_MODEL, IN_PROJ_WIDTH), D_MODEL ** -0.5),
        'w_branch_a': normal(ks[7], (L, SB_WIDTH, D_MODEL), SB_WIDTH ** -0.5),
        'w_branch_b': normal(ks[8], (L, DIL_OUT_WIDTH, D_MODEL), DIL_OUT_WIDTH ** -0.5),
        'w_out': normal(ks[9], (L, D_MODEL, D_MODEL), D_MODEL ** -0.5),
        'g_post_mix': 1.0 + normal(ks[10], (L, D_MODEL), 0.05),
        'g_pre_ffn': 1.0 + normal(ks[11], (L, D_MODEL), 0.05),
        'w_router': normal(ks[12], (L, D_MODEL, N_EXPERTS), D_MODEL ** -0.5),
        'router_bias': normal(ks[13], (L, N_EXPERTS), 0.01),
        'w_exp_gate': normal(ks[14], (L, N_EXPERTS, D_MODEL, EXPERT_DIM), D_MODEL ** -0.5),
        'w_exp_up': normal(ks[15], (L, N_EXPERTS, D_MODEL, EXPERT_DIM), D_MODEL ** -0.5),
        'w_exp_down': normal(ks[16], (L, N_EXPERTS, EXPERT_DIM, D_MODEL), EXPERT_DIM ** -0.5),
        'w_sh_gate': normal(ks[17], (L, D_MODEL, EXPERT_DIM), D_MODEL ** -0.5),
        'w_sh_up': normal(ks[18], (L, D_MODEL, EXPERT_DIM), D_MODEL ** -0.5),
        'w_sh_down': normal(ks[19], (L, EXPERT_DIM, D_MODEL), EXPERT_DIM ** -0.5),
        'g_post_ffn': 1.0 + normal(ks[20], (L, D_MODEL), 0.05),
    }


def reference(x, c, rel_bias, w_ada, b_ada, g_pre_mix, w_in, w_branch_a, w_branch_b, w_out, g_post_mix,
              g_pre_ffn, w_router, router_bias, w_exp_gate, w_exp_up, w_exp_down, w_sh_gate, w_sh_up,
              w_sh_down, g_post_ffn):
    for layer in range(DEPTH):
        mod = jax.nn.silu(c) @ w_ada[layer] + b_ada[layer]
        sh1, sc1, gt1, sh2, sc2, gt2 = jnp.split(mod[:, None, :], N_MOD, axis=-1)
        h = rms_norm(x, g_pre_mix[layer]) * (1.0 + sc1) + sh1
        y = hybrid_mixer(h, w_in[layer], w_branch_a[layer], w_branch_b[layer], w_out[layer], rel_bias)
        x = x + gt1 * rms_norm(y, g_post_mix[layer])
        h = rms_norm(x, g_pre_ffn[layer]) * (1.0 + sc2) + sh2
        y = moe_ffn(h, w_router[layer], router_bias[layer], w_exp_gate[layer], w_exp_up[layer],
                    w_exp_down[layer], w_sh_gate[layer], w_sh_up[layer], w_sh_down[layer])
        x = x + gt2 * rms_norm(y, g_post_ffn[layer])
    return x
```

```cpp
#include <hip/hip_runtime.h>
#include <cstdio>
#include <cstdint>

#define LAS __attribute__((address_space(3)))
#define GAS __attribute__((address_space(1)))
typedef unsigned short bf16;
typedef unsigned v4u __attribute__((ext_vector_type(4)));
typedef unsigned v2u __attribute__((ext_vector_type(2)));
typedef float f32x4 __attribute__((ext_vector_type(4)));
typedef float f32x2 __attribute__((ext_vector_type(2)));
typedef float f32x16 __attribute__((ext_vector_type(16)));
typedef short bf16x8 __attribute__((ext_vector_type(8)));
typedef short s16x4 __attribute__((ext_vector_type(4)));
typedef GAS unsigned gu32;
#define RLX_AGENT __ATOMIC_RELAXED, __HIP_MEMORY_SCOPE_AGENT
#define LDS_WAIT() asm volatile("s_waitcnt lgkmcnt(0)" ::: "memory")
#define VM_WAIT() asm volatile("s_waitcnt vmcnt(0)" ::: "memory")

__device__ __forceinline__ unsigned cvt_pk_bf16(float lo, float hi) { unsigned r; asm volatile("v_cvt_pk_bf16_f32 %0, %1, %2" : "=v"(r) : "v"(lo), "v"(hi)); return r; }
__device__ __forceinline__ float bf_lo(unsigned u) { return __uint_as_float(u << 16); }
__device__ __forceinline__ float bf_hi(unsigned u) { return __uint_as_float(u & 0xffff0000u); }
__device__ __forceinline__ float fexp2(float x) { return __builtin_amdgcn_exp2f(x); }
__device__ __forceinline__ float flog2(float x) { return __builtin_amdgcn_logf(x); }
__device__ __forceinline__ float frcp(float x) { return __builtin_amdgcn_rcpf(x); }
__device__ __forceinline__ float sigmoidf_(float x) { return frcp(1.0f + fexp2(-1.4426950408889634f * x)); }

namespace pg8 {
constexpr int BM = 256, BK = 64, HALF = 128, HTB = HALF * BK * 2  , STAGE_BYTES = 8 * HTB;
__host__ __device__ __forceinline__ int lds_byte(int r, int c) { const int st = (r >> 4) * 2 + (c >> 5), rr = r & 15, cc = c & 31, ob = rr * 64 + cc * 2; return st * 1024 + (ob ^ (((ob >> 9) & 1) << 5)); }
__host__ __device__ __forceinline__ void stage_rc(int b, int& R, int& C) { const int st = b / 1024, sb = b % 1024, swz = sb ^ (((sb >> 9) & 1) << 5); R = (st >> 1) * 16 + swz / 64; C = (st & 1) * 32 + (swz % 64) / 2; }
__host__ __device__ __forceinline__ int perm32(int rho) { const int n = rho >> 4, i = rho & 15; return 8 * (i >> 2) + 4 * n + (i & 3); }

struct Unit {
    const char* A;
    const char* B;
    const int* rows;
    int nvalid;
    int K;
    int lda;
    int kind;
    int r0, c0;
    int e;
};

typedef f32x4 Acc[2][2][4][2];

__device__ __forceinline__ void unit_offsets(const Unit& u, const int (&Rs)[2], const int (&Cs)[2], const int (&RBs)[2], unsigned (&a0)[2], unsigned (&b)[2]) {
#pragma unroll
    for (int i = 0; i < 2; ++i) { a0[i] = (unsigned)(Rs[i] * u.lda + Cs[i]) * 2u; b[i] = (unsigned)(RBs[i] * u.K + Cs[i]) * 2u; }
}
constexpr int GIDX_OFF = 139264;

template <class Epi, class Sched, bool ALIGN_EPI>
__device__ __forceinline__ void gemm_phase(LAS unsigned char* lds, const Sched& S, const Epi& E) {
    constexpr bool GATHER = Sched::GATHER, VAR = Sched::VAR;
    static_assert(!(GATHER && VAR), "gathered phases keep K and the pitch fixed");
    const int tid = threadIdx.x, wid = __builtin_amdgcn_readfirstlane(tid >> 6), lane = tid & 63, wr = wid >> 2, wc = wid & 3, fr = lane & 15, fq = lane >> 4;
    int Rs[2], Cs[2], RBs[2];
#pragma unroll
    for (int i = 0; i < 2; ++i) { int R, C; stage_rc(tid * 16 + i * 8192, R, C); Rs[i] = R; Cs[i] = C; RBs[i] = Epi::PERM ? ((R & ~31) + perm32(R & 31)) : R; }
    const size_t kstep = (size_t)(BK * 2);
    const unsigned ldsw = (unsigned)wid * 1024u;
    const int aoff = lds_byte(wr * 64 + fr, fq * 8), boff = lds_byte(wc * 32 + fr, fq * 8);
#define PG8_SA(b, h) (((b) * 2 + (h)) * HTB)
#define PG8_SB(b, h) ((4 + (b) * 2 + (h)) * HTB)
#define PG8_STAGE(bufoff, gbase, voff) do { _Pragma("unroll") for (int _i = 0; _i < 2; ++_i) \
        __builtin_amdgcn_global_load_lds((const unsigned*)((const char*)(gbase) + (voff)[_i]), (LAS unsigned*)(lds + (bufoff) + ldsw + _i * 8192), 16, 0, 0); } while (0)
#define PG8_STAGE_G(bufoff, gbase, h) do { _Pragma("unroll") for (int _i = 0; _i < 2; ++_i) { const unsigned _ix = (h) ? (pk[_i] >> 16) : (pk[_i] & 0xffffu); \
        __builtin_amdgcn_global_load_lds((const unsigned*)((const char*)(gbase) + (_ix * lda2 + cs2)), (LAS unsigned*)(lds + (bufoff) + ldsw + _i * 8192), 16, 0, 0); } } while (0)
#define PG8_STA(bufoff, p, h, hstep) do { if constexpr (GATHER) PG8_STAGE_G(bufoff, p, h); else PG8_STAGE(bufoff, (p) + ((h) ? (hstep) : 0u), vA0); } while (0)
#define PG8_STB(bufoff, p, h, hstep) PG8_STAGE(bufoff, (p) + ((h) ? (hstep) : 0u), vB)
#define PG8_GLIST(u) do { if ((u).rows) { _Pragma("unroll") for (int _q = 0; _q < 4; ++_q) \
        __builtin_amdgcn_global_load_lds((const unsigned*)((u).rows + _q * 64 + lane), (LAS unsigned*)(lds + GIDX_OFF + ldsw + _q * 256), 4, 0, 0); } } while (0)
#define PG8_GREAD(u) do { const LAS int* _gl = (const LAS int*)(lds + GIDX_OFF + ldsw); _Pragma("unroll") for (int _i = 0; _i < 2; ++_i) { int _i0 = Rs[_i], _i1 = HALF + Rs[_i]; \
        if ((u).rows) { const int _a = _gl[_i0], _b = _gl[_i1]; _i0 = (_i0 < (u).nvalid) ? _a : 0; _i1 = (_i1 < (u).nvalid) ? _b : 0; } pk[_i] = (unsigned)_i0 | ((unsigned)_i1 << 16); } } while (0)
#define PG8_LDA(dst, b, h) do { _Pragma("unroll") for (int m = 0; m < 4; ++m) _Pragma("unroll") for (int k = 0; k < 2; ++k) dst[m][k] = *(const LAS bf16x8*)(lds + PG8_SA(b, h) + aoff + m * 2048 + k * 1024); } while (0)
#define PG8_LDB(dst, b, h) do { _Pragma("unroll") for (int n = 0; n < 2; ++n) _Pragma("unroll") for (int k = 0; k < 2; ++k) dst[n][k] = *(const LAS bf16x8*)(lds + PG8_SB(b, h) + boff + n * 2048 + k * 1024); } while (0)
#define PG8_MMA(ai, bj, At, Bt) do { __builtin_amdgcn_s_setprio(1); _Pragma("unroll") for (int m = 0; m < 4; ++m) _Pragma("unroll") for (int n = 0; n < 2; ++n) _Pragma("unroll") for (int k = 0; k < 2; ++k) \
        acc[ai][bj][m][n] = __builtin_amdgcn_mfma_f32_16x16x32_bf16(Bt[n][k], At[m][k], acc[ai][bj][m][n], 0, 0, 0); __builtin_amdgcn_s_setprio(0); } while (0)
#define PG8_WAIT_V(n) asm volatile("s_waitcnt vmcnt(" #n ")" ::: "memory")
#define PG8_WAIT_L(n) asm volatile("s_waitcnt lgkmcnt(" #n ")" ::: "memory")
#define PG8_BAR __builtin_amdgcn_s_barrier()
#define PG8_SCHED __builtin_amdgcn_sched_barrier(0)
    Unit cur, nxt; int ui = 0;
    if (!S.next(0, cur)) return;
    Acc acc;
#pragma unroll
    for (int a = 0; a < 2; ++a)
#pragma unroll
        for (int b = 0; b < 2; ++b)
#pragma unroll
            for (int m = 0; m < 4; ++m)
#pragma unroll
                for (int n = 0; n < 2; ++n) acc[a][b][m][n] = (f32x4){0.f, 0.f, 0.f, 0.f};
    bf16x8 At[4][2], B0[2][2], B1[2][2];
    unsigned vA0[2], vB[2], pk[2];
    const unsigned cs2 = (unsigned)Cs[0] * 2u, lda2 = (unsigned)cur.lda * 2u;
    const char* cA = cur.A; const char* cB = cur.B; unsigned chB = (unsigned)(HALF * cur.K * 2), chA = (unsigned)(HALF * cur.lda * 2);
    unit_offsets(cur, Rs, Cs, RBs, vA0, vB);
    if constexpr (GATHER) { PG8_GLIST(cur); asm volatile("s_waitcnt vmcnt(0)" ::: "memory"); PG8_GREAD(cur); }
    PG8_STB(PG8_SB(0, 0), cB, 0, chB); PG8_STB(PG8_SB(0, 1), cB, 1, chB); PG8_STA(PG8_SA(0, 0), cA, 0, chA); PG8_STA(PG8_SA(0, 1), cA, 1, chA);
    if (wr == 1) PG8_BAR;
    PG8_WAIT_V(2); PG8_BAR;
    PG8_STB(PG8_SB(1, 0), cB + kstep, 0, chB); PG8_STA(PG8_SA(1, 0), cA + kstep, 0, chA); PG8_STB(PG8_SB(1, 1), cB + kstep, 1, chB);
    PG8_WAIT_V(6); PG8_BAR;
    for (;;) {
        const bool has_next = S.next(ui + 1, nxt);
        const char* nA = cA; const char* nB = cB; unsigned nhB = chB, nhA = chA;
        if (has_next) { nA = nxt.A; nB = nxt.B; nhB = (unsigned)(HALF * nxt.K * 2); nhA = (unsigned)(HALF * nxt.lda * 2); if constexpr (GATHER) PG8_GLIST(nxt); }
        const int nt = cur.K / BK;
#pragma unroll 1
        for (int t = 0; t < nt; t += 2) {
            const bool last = (t == nt - 2);
            const char* a1 = cA + (size_t)(t + 1) * kstep;
            const char* a2 = last ? nA : cA + (size_t)(t + 2) * kstep; const char* b2 = last ? nB : cB + (size_t)(t + 2) * kstep;
            const char* a3 = a2 + kstep; const char* b3 = b2 + kstep;
            const unsigned whB = last ? nhB : chB, whA = last ? nhA : chA;
            PG8_LDB(B0, 0, 0); PG8_LDB(B1, 0, 1); PG8_SCHED; PG8_LDA(At, 0, 0); PG8_STA(PG8_SA(1, 1), a1, 1, chA);
            PG8_WAIT_V(8); PG8_WAIT_L(0); PG8_BAR; PG8_MMA(0, 0, At, B0); PG8_MMA(0, 1, At, B1); PG8_BAR; PG8_SCHED;
            if constexpr (VAR) { if (last && has_next) unit_offsets(nxt, Rs, Cs, RBs, vA0, vB); }
            if constexpr (GATHER) { if (last && has_next) PG8_GREAD(nxt); }
            PG8_LDA(At, 0, 1); PG8_STB(PG8_SB(0, 0), b2, 0, whB); PG8_STB(PG8_SB(0, 1), b2, 1, whB); PG8_STA(PG8_SA(0, 0), a2, 0, whA);
            PG8_WAIT_V(8); PG8_WAIT_L(0); PG8_BAR; PG8_MMA(1, 0, At, B0); PG8_MMA(1, 1, At, B1); PG8_BAR; PG8_SCHED;
            PG8_LDB(B0, 1, 0); PG8_LDB(B1, 1, 1); PG8_SCHED; PG8_LDA(At, 1, 0); PG8_STA(PG8_SA(0, 1), a2, 1, whA);
            PG8_WAIT_V(8); PG8_WAIT_L(0); PG8_BAR; PG8_MMA(0, 0, At, B0); PG8_MMA(0, 1, At, B1); PG8_BAR; PG8_SCHED;
            PG8_LDA(At, 1, 1); PG8_STB(PG8_SB(1, 0), b3, 0, whB); PG8_STB(PG8_SB(1, 1), b3, 1, whB); PG8_STA(PG8_SA(1, 0), a3, 0, whA);
            PG8_WAIT_V(8); PG8_WAIT_L(0); PG8_BAR; PG8_MMA(1, 0, At, B0); PG8_MMA(1, 1, At, B1); PG8_BAR; PG8_SCHED;
        }
        if constexpr (ALIGN_EPI) { if (wr == 0) PG8_BAR; }
        E(acc, cur, wr, wc, fr, fq);
        if (!has_next) break;
#pragma unroll
        for (int a = 0; a < 2; ++a)
#pragma unroll
            for (int b = 0; b < 2; ++b)
#pragma unroll
                for (int m = 0; m < 4; ++m)
#pragma unroll
                    for (int n = 0; n < 2; ++n) acc[a][b][m][n] = (f32x4){0.f, 0.f, 0.f, 0.f};
        cur = nxt; cA = nA; cB = nB; chB = nhB; chA = nhA; ++ui;
        if constexpr (ALIGN_EPI) { if (wr == 1) PG8_BAR; }
    }
    PG8_WAIT_V(0);
    if constexpr (!ALIGN_EPI) { if (wr == 0) PG8_BAR; }
    PG8_BAR;
#undef PG8_SA
#undef PG8_SB
#undef PG8_STAGE
#undef PG8_STAGE_G
#undef PG8_STA
#undef PG8_STB
#undef PG8_GLIST
#undef PG8_GREAD
#undef PG8_LDA
#undef PG8_LDB
#undef PG8_MMA
#undef PG8_WAIT_V
#undef PG8_WAIT_L
#undef PG8_BAR
#undef PG8_SCHED
}
}
namespace att {
constexpr int SEQ = 4096, PW = 5888;
constexpr int C_SBQ = 0, C_SBK = 512, C_SBV = 1024, C_DQ = 1536, C_DK = 2304, C_DV = 3072;
constexpr int SLOTB = 8192, NSLOT = 3;
constexpr int LDS_K = 0, LDS_V = NSLOT * SLOTB, LDS_WS = 2 * NSLOT * SLOTB  , LDS_FLAG = LDS_WS + 8 * 256  , LDS_BIAS = LDS_FLAG + 64  ,
              LDS_OST = LDS_BIAS + 544, LDS_BYTES = LDS_OST + 8 * 4096;
static_assert(LDS_OST % 16 == 0, "O stage alignment");
constexpr float L2E = 1.4426950408889634f;
constexpr float SB_DONE_THR = -160.0f;
__device__ __forceinline__ int crow(int r, int hi) { return (r & 3) + 8 * (r >> 2) + 4 * hi; }
__device__ __forceinline__ void glds16(const void* gsrc, unsigned lds_dst) { unsigned keep;
    asm volatile("s_mov_b32 %0, m0\n\ts_mov_b32 m0, %2\n\ts_nop 0\n\tglobal_load_lds_dwordx4 %1, off\n\ts_mov_b32 m0, %0" : "=&s"(keep) : "v"(gsrc), "s"(lds_dst) : "memory"); }
#define ATT_WAIT_BAR(N) asm volatile("s_waitcnt vmcnt(" #N ") lgkmcnt(0)\n\ts_barrier" ::: "memory")
typedef LAS const char* lds_cptr;
typedef short v4i16_t __attribute__((ext_vector_type(4)));
__device__ __forceinline__ s16x4 vtr(lds_cptr p) { return __builtin_bit_cast(s16x4, __builtin_amdgcn_ds_read_tr16_b64_v4i16((LAS v4i16_t*)p)); }
__device__ __forceinline__ float other_half(float x, int hi) { auto rr = __builtin_amdgcn_permlane32_swap(__float_as_uint(x), __float_as_uint(x), false, false); return __uint_as_float(hi ? rr[0] : rr[1]); }

__device__ __forceinline__ void qkt(f32x16& p0, f32x16& p1, lds_cptr kp, const bf16x8* qr) {
    const f32x16 z = {};
    p0 = z; p1 = z;
#pragma unroll
    for (int d0 = 0; d0 < 4; ++d0) {
        const bf16x8 k0 = *(const LAS bf16x8*)(kp + d0 * 2048), k1 = *(const LAS bf16x8*)(kp + d0 * 2048 + 512);
        p0 = __builtin_amdgcn_mfma_f32_32x32x16_bf16(k0, qr[d0], p0, 0, 0, 0);
        p1 = __builtin_amdgcn_mfma_f32_32x32x16_bf16(k1, qr[d0], p1, 0, 0, 0);
    }
}
__device__ __forceinline__ void pv(f32x16* o, lds_cptr vp, const f32x16& p0, const f32x16& p1) {
    v4u pw[4];
#pragma unroll
    for (int i = 0; i < 4; ++i) { pw[0][i] = cvt_pk_bf16(p0[2 * i], p0[2 * i + 1]); pw[1][i] = cvt_pk_bf16(p0[8 + 2 * i], p0[9 + 2 * i]);
                                  pw[2][i] = cvt_pk_bf16(p1[2 * i], p1[2 * i + 1]); pw[3][i] = cvt_pk_bf16(p1[8 + 2 * i], p1[9 + 2 * i]); }
#pragma unroll
    for (int d0 = 0; d0 < 2; ++d0)
#pragma unroll
        for (int ks = 0; ks < 4; ++ks) {
            const s16x4 lo = vtr(vp + d0 * 4096 + ks * 1024), hh = vtr(vp + d0 * 4096 + ks * 1024 + 512);
            const bf16x8 vf = (bf16x8){lo[0], lo[1], lo[2], lo[3], hh[0], hh[1], hh[2], hh[3]};
            o[d0] = __builtin_amdgcn_mfma_f32_32x32x16_bf16(__builtin_bit_cast(bf16x8, pw[ks]), vf, o[d0], 0, 0, 0);
        }
}
__device__ __forceinline__ void store_o(const f32x16* o, char* shm, int wid, int lane, bf16* Orow0, long rstride) {
    const int r32 = lane & 31, hi = lane >> 5;
    LAS bf16* stg = (LAS bf16*)(LAS char*)(shm + LDS_OST) + wid * 2048;
#pragma unroll
    for (int r = 0; r < 16; ++r) { const int orow = crow(r, hi);
#pragma unroll
        for (int d0 = 0; d0 < 2; ++d0) stg[orow * 64 + d0 * 32 + r32] = (bf16)(cvt_pk_bf16(o[d0][r], 0.f) & 0xffffu); }
    LDS_WAIT();
#pragma unroll
    for (int i = 0; i < 4; ++i) { const int row = i * 8 + (lane >> 3), ch = lane & 7; const v4u v = *(const LAS v4u*)(stg + row * 64 + ch * 8); *(v4u*)(Orow0 + (long)row * rstride + ch * 8) = v; }
}

__device__ __forceinline__ void sb_unit(int b, int h, int qb, const bf16* proj, bf16* sbo, char* shm) {
    const int tid = threadIdx.x, lane = tid & 63, r32 = lane & 31, hi = lane >> 5; const int wid = __builtin_amdgcn_readfirstlane(tid >> 6);
    const long rowbase = (long)b * SEQ; const int q0 = qb * 256;
    const bf16* Qw = proj + (rowbase + q0 + wid * 32) * PW + C_SBQ + h * 64;
    const bf16* Kh = proj + rowbase * PW + C_SBK + h * 64; const bf16* Vh = proj + rowbase * PW + C_SBV + h * 64;
    const unsigned lds0 = (unsigned)(uintptr_t)shm;
    const bf16* ksrc = Kh + (long)lane * PW + wid * 8;
    const bf16* vsrc = Vh + (long)(16 * (wid & 3) + (lane >> 2)) * PW + (wid >> 2) * 32 + (lane & 3) * 8;
    const unsigned kdst = lds0 + LDS_K + wid * 1024, vdst = lds0 + LDS_V + wid * 1024;
#define DMA_K(t, slot) glds16(ksrc + (long)(t) * 64 * PW, (unsigned)__builtin_amdgcn_readfirstlane(kdst + (slot)))
#define DMA_V(t, slot) glds16(vsrc + (long)(t) * 64 * PW, (unsigned)__builtin_amdgcn_readfirstlane(vdst + (slot)))
    const lds_cptr shm3 = (lds_cptr)shm; const lds_cptr kp0 = shm3 + LDS_K + hi * 1024 + r32 * 16;
    const lds_cptr vp0 = shm3 + LDS_V + ((lane >> 4) & 1) * 32 + (lane & 3) * 8 + (4 * hi + ((lane & 15) >> 2)) * 64;
    volatile LAS unsigned* flags = (volatile LAS unsigned*)(LAS char*)(shm + LDS_FLAG);
    const int kt_hi = q0 / 64 + 3;
    DMA_K(kt_hi, 0); DMA_V(kt_hi, 0);
    bf16x8 qr[4];
#pragma unroll
    for (int d0 = 0; d0 < 4; ++d0) qr[d0] = *reinterpret_cast<const bf16x8*>(&Qw[(long)r32 * PW + d0 * 16 + hi * 8]);
    const int wq_lo = q0 + wid * 32, q = wq_lo + r32;
    float carry = 0.f; f32x16 o[2]; o[0] = f32x16{}; o[1] = f32x16{};
    bool wdone = false; int slot = 0, it = 0;
    for (int kt = kt_hi; kt >= 0; --kt, ++it) {
        const int nslot = (slot == (NSLOT - 1) * SLOTB) ? 0 : slot + SLOTB;
        if (kt > 0) { DMA_K(kt - 1, nslot); DMA_V(kt - 1, nslot); ATT_WAIT_BAR(2); } else { ATT_WAIT_BAR(0); }
        if (it > 0) {
            const int pb = ((it - 1) & 1) * 8; unsigned all = 1u;
#pragma unroll
            for (int w = 0; w < 8; ++w) all &= flags[pb + w];
            if (all) break;
        }
        const bool need = !wdone && (64 * kt < wq_lo + 31);
        if (need) {
            f32x16 p0, p1; qkt(p0, p1, kp0 + slot, qr);
            const bool diag = (64 * kt + 63 >= wq_lo);
            f32x16 l0, l1;
#pragma unroll
            for (int r = 0; r < 16; ++r) {
                { const float z = p0[r]; const float lg = flog2(1.0f + fexp2(-__builtin_fabsf(z))); float ls = __builtin_fminf(z, 0.f) - lg; float lk = ls - z;
                  if (diag) { const bool valid = (64 * kt + crow(r, hi)) < q; lk = valid ? lk : 0.f; ls = valid ? ls : -1e30f; }
                  p0[r] = ls; l0[r] = lk; }
                { const float z = p1[r]; const float lg = flog2(1.0f + fexp2(-__builtin_fabsf(z))); float ls = __builtin_fminf(z, 0.f) - lg; float lk = ls - z;
                  if (diag) { const bool valid = (64 * kt + 32 + crow(r, hi)) < q; lk = valid ? lk : 0.f; ls = valid ? ls : -1e30f; }
                  p1[r] = ls; l1[r] = lk; }
            }
            float og[9];
#pragma unroll
            for (int i = 0; i < 4; ++i) { og[i] = (l0[4 * i] + l0[4 * i + 1]) + (l0[4 * i + 2] + l0[4 * i + 3]); og[4 + i] = (l1[4 * i] + l1[4 * i + 1]) + (l1[4 * i + 2] + l1[4 * i + 3]); }
            og[8] = 0.f;
#pragma unroll
            for (int i = 7; i >= 0; --i) og[i] += og[i + 1];
            float xg[9];
#pragma unroll
            for (int i = 0; i < 8; ++i) xg[i] = other_half(og[i], hi);
            xg[8] = 0.f;
            const float total = og[0] + xg[0];
#pragma unroll
            for (int i = 0; i < 8; ++i) {
                const float sg = carry + og[i + 1] + (hi ? xg[i + 1] : xg[i]);
                if (i < 4) { const float a3 = sg, a2 = a3 + l0[4 * i + 3], a1 = a2 + l0[4 * i + 2], a0 = a1 + l0[4 * i + 1];
                    p0[4 * i] = fexp2(p0[4 * i] + a0); p0[4 * i + 1] = fexp2(p0[4 * i + 1] + a1); p0[4 * i + 2] = fexp2(p0[4 * i + 2] + a2); p0[4 * i + 3] = fexp2(p0[4 * i + 3] + a3); }
                else { const int j = i - 4; const float a3 = sg, a2 = a3 + l1[4 * j + 3], a1 = a2 + l1[4 * j + 2], a0 = a1 + l1[4 * j + 1];
                    p1[4 * j] = fexp2(p1[4 * j] + a0); p1[4 * j + 1] = fexp2(p1[4 * j + 1] + a1); p1[4 * j + 2] = fexp2(p1[4 * j + 2] + a2); p1[4 * j + 3] = fexp2(p1[4 * j + 3] + a3); }
            }
            carry += total;
            pv(o, vp0 + slot, p0, p1);
            wdone = __all(carry < SB_DONE_THR) != 0;
        }
        if (lane == 0) flags[(it & 1) * 8 + wid] = wdone ? 1u : 0u;
        slot = nslot;
    }
    asm volatile("s_waitcnt vmcnt(0) lgkmcnt(0)\n\ts_barrier" ::: "memory");
    bf16* Ow = sbo + (rowbase + q0 + wid * 32) * 512 + h * 64;
    store_o(o, shm, wid, lane, Ow, 512);
    asm volatile("s_waitcnt lgkmcnt(0)\n\ts_barrier" ::: "memory");
#undef DMA_K
#undef DMA_V
}

__device__ __forceinline__ int t5_bucket(int dist) {
    if (dist < 16) return dist;
    const float d = (float)dist; int large = 16 + (int)(logf(d / 16.0f) / 4.852030263919617f * 16.0f);
    return large < 31 ? large : 31;
}
__device__ __forceinline__ void dil_unit(int b, int g, int c, int j, int qblk, const bf16* proj, const float* rel_bias, bf16* dilo, float* lse, char* shm) {
    const int tid = threadIdx.x, lane = tid & 63, r32 = lane & 31, hi = lane >> 5; const int wid = __builtin_amdgcn_readfirstlane(tid >> 6);
    const int r = (g == 0) ? 1 : (g == 1) ? 4 : 16;
    const long rowbase = (long)b * SEQ; const int n0 = qblk * 256; const int hd = (g * 4 + j) * 64;
    const bf16* Qb = proj + rowbase * PW + C_DQ + hd; const bf16* Kb = proj + rowbase * PW + C_DK + hd; const bf16* Vb = proj + rowbase * PW + C_DV + hd;
    const unsigned lds0 = (unsigned)(uintptr_t)shm;
    const unsigned kdst = lds0 + LDS_K + wid * 1024, vdst = lds0 + LDS_V + wid * 1024;
    const int vrow = 16 * (wid & 3) + (lane >> 2), vcol = (wid >> 2) * 32 + (lane & 3) * 8;
#define DDMA_K(kn0, slot) glds16(Kb + ((long)((kn0) + lane) * r + c) * PW + wid * 8, (unsigned)__builtin_amdgcn_readfirstlane(kdst + (slot)))
#define DDMA_V(kn0, slot) glds16(Vb + ((long)((kn0) + vrow) * r + c) * PW + vcol, (unsigned)__builtin_amdgcn_readfirstlane(vdst + (slot)))
    const lds_cptr shm3 = (lds_cptr)shm; const lds_cptr kp0 = shm3 + LDS_K + hi * 1024 + r32 * 16;
    const lds_cptr vp0 = shm3 + LDS_V + ((lane >> 4) & 1) * 32 + (lane & 3) * 8 + (4 * hi + ((lane & 15) >> 2)) * 64;
    LAS float* wsf = (LAS float*)(LAS char*)(shm + LDS_WS) + wid * 64;
    LAS float* bias2 = (LAS float*)(LAS char*)(shm + LDS_BIAS);
    if (tid <= 128) bias2[tid] = rel_bias[t5_bucket(tid * r) * 12 + g * 4 + j] * L2E;
    const int ti0 = (n0 == 0) ? 2 : 0;
    DDMA_K(n0 - 128 + 64 * ti0, 0); DDMA_V(n0 - 128 + 64 * ti0, 0);
    const int nq_lo = n0 + wid * 32, nq = nq_lo + r32;
    bf16x8 qr[4];
    { const bf16* Ql = Qb + ((long)nq * r + c) * PW;
#pragma unroll
      for (int d0 = 0; d0 < 4; ++d0) qr[d0] = *reinterpret_cast<const bf16x8*>(&Ql[d0 * 16 + hi * 8]); }
    float m = -1e30f, l = 0.f; f32x16 o[2]; o[0] = f32x16{}; o[1] = f32x16{};
    int slot = 0;
    for (int ti = ti0; ti < 6; ++ti) {
        const int nslot = (slot == (NSLOT - 1) * SLOTB) ? 0 : slot + SLOTB;
        const int kn0 = n0 - 128 + 64 * ti;
        if (ti < 5) { DDMA_K(kn0 + 64, nslot); DDMA_V(kn0 + 64, nslot); ATT_WAIT_BAR(2); } else { ATT_WAIT_BAR(0); }
        const bool need = (kn0 + 63 >= nq_lo - 128) && (kn0 <= nq_lo + 31);
        if (need) {
            f32x16 p0, p1; qkt(p0, p1, kp0 + slot, qr);
            float rm = -INFINITY;
#pragma unroll
            for (int rr = 0; rr < 16; ++rr) {
                { const int dist = nq - (kn0 + crow(rr, hi)); const bool valid = (unsigned)dist <= 128u; const float bv = bias2[valid ? dist : 0];
                  const float s = valid ? p0[rr] + bv : -INFINITY; p0[rr] = s; rm = __builtin_fmaxf(rm, s); }
                { const int dist = nq - (kn0 + 32 + crow(rr, hi)); const bool valid = (unsigned)dist <= 128u; const float bv = bias2[valid ? dist : 0];
                  const float s = valid ? p1[rr] + bv : -INFINITY; p1[rr] = s; rm = __builtin_fmaxf(rm, s); }
            }
            rm = __builtin_fmaxf(rm, other_half(rm, hi));
            const float mn = __builtin_fmaxf(m, rm); const float alpha = fexp2(m - mn); m = mn;
            float ps = 0.f;
#pragma unroll
            for (int rr = 0; rr < 16; ++rr) { p0[rr] = fexp2(p0[rr] - mn); p1[rr] = fexp2(p1[rr] - mn); ps += p0[rr] + p1[rr]; }
            l = l * alpha + ps;
            if (__any(alpha != 1.0f)) {
                if (hi == 0) wsf[r32] = alpha;
                LDS_WAIT();
#pragma unroll
                for (int rr = 0; rr < 16; ++rr) { const float f = wsf[crow(rr, hi)]; o[0][rr] *= f; o[1][rr] *= f; }
                LDS_WAIT();
            }
            pv(o, vp0 + slot, p0, p1);
        }
        slot = nslot;
    }
    l += other_half(l, hi);
    if (hi == 0) wsf[32 + r32] = frcp(l);
    LDS_WAIT();
#pragma unroll
    for (int rr = 0; rr < 16; ++rr) { const float f = wsf[32 + crow(rr, hi)]; o[0][rr] *= f; o[1][rr] *= f; }
    const long tok0 = rowbase + (long)nq_lo * r + c;
    if (hi == 0) lse[(size_t)g * (8 * SEQ * 4) + (size_t)(tok0 + (long)r32 * r) * 4 + j] = m + flog2(l);
    asm volatile("s_waitcnt lgkmcnt(0)" ::: "memory");
    store_o(o, shm, wid, lane, dilo + (size_t)g * ((size_t)8 * SEQ * 256) + (size_t)tok0 * 256 + j * 64, (long)r * 256);
    asm volatile("s_waitcnt vmcnt(0) lgkmcnt(0)\n\ts_barrier" ::: "memory");
#undef DDMA_K
#undef DDMA_V
}
#undef ATT_WAIT_BAR
}
constexpr int NWAVES = 8;
constexpr int NB = 8, SEQ = 4096, DM = 1024, NTOK = NB * SEQ, PW = 5888, NMOD = 6 * DM;
constexpr int C_GA = 3840, C_GB = 4864;
constexpr int NE = 256, TOPK = 8, EDIM = 256, NSLOTS = NTOK * TOPK;
constexpr float EPS = 1e-6f, ROUTED_SCALE = 2.5f;
constexpr float QSCALE = 0.125f * 1.4426950408889634f;

constexpr size_t MiB = 1u << 20;
constexpr size_t WS_CTL = 0, CTL_ZERO_BYTES = 1 * MiB;
constexpr size_t WS_MOD = 1 * MiB;
constexpr size_t WS_TOKE = 2 * MiB;
constexpr size_t WS_TOKW = 3 * MiB;
constexpr size_t WS_SLOTTOK = 4 * MiB;
constexpr size_t WS_SLOTW = 6 * MiB;
constexpr size_t WS_TOKROW = 8 * MiB;
constexpr size_t WS_LSE = 9 * MiB;
constexpr size_t WS_WIN = 16 * MiB, WS_WBA = 28 * MiB, WS_WBB = 29 * MiB, WS_WOUT = 30 * MiB, WS_WR = 32 * MiB;
constexpr size_t WS_PROJ = 48 * MiB;
constexpr size_t WS_H1 = 416 * MiB;
constexpr size_t WS_SBO = 480 * MiB;
constexpr size_t WS_DILO = 512 * MiB;
constexpr size_t WS_DILM = 560 * MiB;
constexpr size_t WS_MERGED = 640 * MiB;
constexpr size_t WS_Y = 704 * MiB;
constexpr size_t WS_H2 = 840 * MiB;
constexpr size_t WS_WGU = 48 * MiB;
constexpr size_t WS_SCORES = 400 * MiB;
constexpr size_t WS_YS = 48 * MiB;
constexpr size_t WS_WD = 560 * MiB;
constexpr size_t WS_H = 690 * MiB;
constexpr size_t WS_HS = 820 * MiB;
constexpr size_t WS_YTOT = 560 * MiB;
constexpr size_t WS_END = 904 * MiB;
static_assert(WS_WGU + (size_t)257 * 512 * 1024 * 2 <= WS_SCORES && WS_WD + (size_t)257 * 1024 * 256 * 2 <= WS_H && WS_H + (size_t)(NSLOTS + 256) * 256 * 2 <= WS_HS && WS_HS + (size_t)NTOK * 256 * 2 <= WS_H2, "late map");
static_assert(WS_YS + (size_t)NSLOTS * 1024 * 2 <= WS_WD && WS_YTOT + (size_t)NTOK * 1024 * 4 <= WS_WD + (size_t)256 * 1024 * 256 * 2, "late map 2");
constexpr int CW_TMO = 0, CW_CODE = 1, CW_BAR = 4096, CW_CNT = 8192;

constexpr int RING_BYTES = 131072, LDSCTL_OFF = RING_BYTES, MISC_OFF = LDSCTL_OFF + 320, TAB_OFF = LDSCTL_OFF + 1024;
constexpr int TAB_TSTART = TAB_OFF, TAB_RSTART = TAB_OFF + 1088, TAB_CNT = TAB_OFF + 2176;
constexpr int LDS_BYTES = 147456;
static_assert(TAB_CNT + 1024 <= LDS_BYTES && att::LDS_BYTES <= RING_BYTES, "LDS map");

#define XB_TMO      128
#define XB_XCNT(j)  (256  + 64 * (j))
#define XB_XSUB(j)  (1280 + 64 * (j))
#define XB_XGEN(j)  (2304 + 64 * (j))
#define XB_TOP      3328
#define XB_TOPGEN   3392
#define XCD_BAR_WORDS 3456
#define XB_SPIN_CAP (1u << 18)
__device__ __forceinline__ unsigned xb_ld(unsigned* p)              { return __hip_atomic_load(p, __ATOMIC_RELAXED, __HIP_MEMORY_SCOPE_AGENT); }
__device__ __forceinline__ unsigned xb_add(unsigned* p, unsigned v) { return __hip_atomic_fetch_add(p, v, __ATOMIC_RELAXED, __HIP_MEMORY_SCOPE_AGENT); }
__device__ __forceinline__ unsigned xb_xcc_id() { return (unsigned)__builtin_amdgcn_s_getreg((3 << 11) | 20) & 0xFu; }
#define XB_SPIN(cond, bar) do { unsigned _sp = 0; while (cond) { __builtin_amdgcn_s_sleep(1); \
    if ((++_sp & 255u) == 0u) { if (xb_ld(&(bar)[XB_TMO])) break; if (_sp > XB_SPIN_CAP) { atomicAdd(&(bar)[XB_TMO], 1u); break; } } } } while (0)
struct XcdBarrier { unsigned* bar; unsigned x; volatile LAS unsigned* st; };
__device__ __forceinline__ XcdBarrier xcd_barrier_post(unsigned* bar, volatile LAS unsigned* st) {
    XcdBarrier b; b.bar = bar; b.x = xb_xcc_id(); b.st = st;
    if (threadIdx.x == 0) (void)xb_add(&bar[XB_XCNT(b.x)], 1u);
    return b;
}
__device__ __forceinline__ void xcd_barrier_complete(unsigned* bar, unsigned x, unsigned& nloc, unsigned& nx) {
    const unsigned G = gridDim.x * gridDim.y * gridDim.z;
    unsigned sum, cnt, mine, sp = 0u;
    for (;;) {
        sum = 0u; cnt = 0u; mine = 0u;
#pragma unroll
        for (unsigned j = 0; j < 16; ++j) { const unsigned c = xb_ld(&bar[XB_XCNT(j)]); sum += c; cnt += (c > 0u) ? 1u : 0u; mine = (j == x) ? c : mine; }
        if (sum == G) break;
        __builtin_amdgcn_s_sleep(1);
        if ((++sp & 255u) == 0u) { if (xb_ld(&bar[XB_TMO])) break; if (sp > XB_SPIN_CAP) { atomicAdd(&bar[XB_TMO], 1u); break; } }
    }
    nloc = mine > 0u ? mine : 1u; nx = cnt > 0u ? cnt : 1u;
}
__device__ __forceinline__ void xcd_barrier(const XcdBarrier& b) {
    asm volatile("s_waitcnt vmcnt(0)" ::: "memory");
    __syncthreads();
    if (threadIdx.x == 0) {
        unsigned* bar = b.bar;
        __builtin_amdgcn_s_waitcnt(0);
        unsigned nloc = b.st[0], nx = b.st[1];
        if (nloc == 0u) { xcd_barrier_complete(bar, b.x, nloc, nx); b.st[0] = nloc; b.st[1] = nx; }
        const unsigned old = xb_add(&bar[XB_XSUB(b.x)], 1u);
        const unsigned gen = old / nloc;
        if (old + 1u == (gen + 1u) * nloc) {
            __builtin_amdgcn_fence(__ATOMIC_RELEASE, "agent");
            asm volatile("s_waitcnt vmcnt(0)" ::: "memory");
            const unsigned og = xb_add(&bar[XB_TOP], 1u);
            const unsigned tg = og / nx;
            if (og + 1u == (tg + 1u) * nx) xb_add(&bar[XB_TOPGEN], 1u);
            else XB_SPIN(xb_ld(&bar[XB_TOPGEN]) == tg, bar);
            __builtin_amdgcn_fence(__ATOMIC_ACQUIRE, "agent");
            xb_add(&bar[XB_XGEN(b.x)], 1u);
            asm volatile("s_waitcnt vmcnt(0)" ::: "memory");
        } else {
            XB_SPIN(xb_ld(&bar[XB_XGEN(b.x)]) == gen, bar);
            __builtin_amdgcn_fence(__ATOMIC_ACQUIRE, "agent");
            asm volatile("s_waitcnt vmcnt(0)" ::: "memory");
        }
    }
    __syncthreads();
}

struct Frame {
    LAS unsigned char* lds; volatile LAS unsigned* MISC; unsigned* ctl;
    int tid, lane, wave, vcu, G;
    const float* in[21]; float* out; unsigned char* ws;
};
__device__ __forceinline__ float wave_sum(float v) {
#pragma unroll
    for (int o = 1; o < 64; o <<= 1) v += __shfl_xor(v, o);
    return v;
}
__device__ __forceinline__ v2u pack4(f32x4 v) { v2u r; r.x = cvt_pk_bf16(v.x, v.y); r.y = cvt_pk_bf16(v.z, v.w); return r; }

__device__ __forceinline__ void tr_item(const float* W, int N, int k0, int n0, bf16* dst, int ldk, LAS float* scr, int lane) {
    f32x4 v[8];
#pragma unroll
    for (int j = 0; j < 8; ++j) v[j] = *(const f32x4*)(W + (size_t)(k0 + j * 8 + (lane >> 3)) * N + n0 + (lane & 7) * 4);
#pragma unroll
    for (int j = 0; j < 8; ++j) { LAS float* s = scr + (j * 8 + (lane >> 3)) * 33 + (lane & 7) * 4; s[0] = v[j].x; s[1] = v[j].y; s[2] = v[j].z; s[3] = v[j].w; }
    LDS_WAIT(); asm volatile("" ::: "memory");
    const int c = lane & 7;
#pragma unroll
    for (int j = 0; j < 4; ++j) { const int n = (lane >> 3) + 8 * j; const LAS float* s = scr + (8 * c) * 33 + n;
        v4u o; o.x = cvt_pk_bf16(s[0 * 33], s[1 * 33]); o.y = cvt_pk_bf16(s[2 * 33], s[3 * 33]); o.z = cvt_pk_bf16(s[4 * 33], s[5 * 33]); o.w = cvt_pk_bf16(s[6 * 33], s[7 * 33]);
        *(v4u*)(dst + (size_t)n * ldk + k0 + 8 * c) = o; }
    LDS_WAIT(); asm volatile("" ::: "memory");
}

__device__ __forceinline__ void phase_mod_smallw(Frame& F) {
    const float* c = F.in[1]; const float* w_ada = F.in[3]; const float* b_ada = F.in[4]; float* mod = (float*)(F.ws + WS_MOD);
    LAS float* sc = (LAS float*)F.lds; LAS float* part = (LAS float*)(F.lds + 32768);
    for (int i = F.tid; i < NB * DM; i += NWAVES * 64) { const float v = c[i]; sc[i] = v * sigmoidf_(v); }
    __syncthreads();
    for (int cb = blockIdx.x; cb < 256; cb += F.G) {
        if (F.tid < 504) {
            const int col = F.tid % 24, ks = F.tid / 24, k0 = ks * 49, k1 = (k0 + 49 < DM) ? k0 + 49 : DM;
            float a[8];
#pragma unroll
            for (int b = 0; b < 8; ++b) a[b] = 0.f;
            for (int k = k0; k < k1; ++k) { const float w = w_ada[(size_t)k * NMOD + cb * 24 + col];
#pragma unroll
                for (int b = 0; b < 8; ++b) a[b] += sc[b * DM + k] * w; }
#pragma unroll
            for (int b = 0; b < 8; ++b) part[(ks * 24 + col) * 8 + b] = a[b];
        }
        __syncthreads();
        if (F.tid < 192) { const int col = F.tid >> 3, b = F.tid & 7; float s = b_ada[cb * 24 + col];
            for (int ks = 0; ks < 21; ++ks) s += part[(ks * 24 + col) * 8 + b];
            mod[b * NMOD + cb * 24 + col] = s; }
        __syncthreads();
    }
    LAS float* scr = (LAS float*)(F.lds + F.wave * 16384);
    const int gw = F.vcu * NWAVES + F.wave, NGW = F.G * NWAVES;
    constexpr int I_IN = 16 * 184, I_BA = 8 * 32, I_BB = 4 * 32, I_OUT = 16 * 32, I_R = 16 * 8, NIT = I_IN + I_BA + I_BB + I_OUT + I_R;
    for (int it = gw; it < NIT; it += NGW) {
        int r = it;
        if (r < I_IN) { const int kb = r / 184, nb = r % 184; tr_item(F.in[6], PW, 64 * kb, 32 * nb, (bf16*)(F.ws + WS_WIN) + (size_t)(32 * nb) * 1024, 1024, scr, F.lane); continue; } r -= I_IN;
        if (r < I_BA) { const int kb = r / 32, nb = r % 32; tr_item(F.in[7], DM, 64 * kb, 32 * nb, (bf16*)(F.ws + WS_WBA) + (size_t)(32 * nb) * 512, 512, scr, F.lane); continue; } r -= I_BA;
        if (r < I_BB) { const int kb = r / 32, nb = r % 32; tr_item(F.in[8], DM, 64 * kb, 32 * nb, (bf16*)(F.ws + WS_WBB) + (size_t)(32 * nb) * 256, 256, scr, F.lane); continue; } r -= I_BB;
        if (r < I_OUT) { const int kb = r / 32, nb = r % 32; tr_item(F.in[9], DM, 64 * kb, 32 * nb, (bf16*)(F.ws + WS_WOUT) + (size_t)(32 * nb) * 1024, 1024, scr, F.lane); continue; } r -= I_OUT;
        { const int kb = r / 8, nb = r % 8; tr_item(F.in[12], NE, 64 * kb, 32 * nb, (bf16*)(F.ws + WS_WR) + (size_t)(32 * nb) * 1024, 1024, scr, F.lane); }
    }
}
__device__ __forceinline__ void phase_expert_weights(Frame& F) {
    LAS float* scr = (LAS float*)(F.lds + F.wave * 16384);
    const int gw = F.vcu * NWAVES + F.wave, NGW = F.G * NWAVES;
    constexpr int PER = 257 * 128;
    for (int it = gw; it < 3 * PER; it += NGW) {
        const int which = it / PER, rem = it % PER, e = rem >> 7, kn = rem & 127;
        if (which < 2) {
            const float* W = (e < NE) ? (which ? F.in[15] : F.in[14]) + (size_t)e * DM * EDIM : (which ? F.in[18] : F.in[17]);
            const int kb = kn >> 3, nb = kn & 7, n0 = 32 * nb;
            bf16* dst = (bf16*)(F.ws + WS_WGU) + ((size_t)e * 512 + (size_t)(n0 >> 7) * 256 + which * 128 + (n0 & 127)) * 1024;
            tr_item(W, EDIM, 64 * kb, n0, dst, 1024, scr, F.lane);
        } else {
            const float* W = (e < NE) ? F.in[16] + (size_t)e * EDIM * DM : F.in[19];
            const int kb = kn >> 5, nb = kn & 31;
            bf16* dst = (bf16*)(F.ws + WS_WD) + ((size_t)e * 1024 + 32 * nb) * 256;
            tr_item(W, DM, 64 * kb, 32 * nb, dst, 256, scr, F.lane);
        }
    }
}
__device__ __forceinline__ void phase_h1(Frame& F) {
    const float* x = F.in[0]; const float* g = F.in[5]; const float* mod = (const float*)(F.ws + WS_MOD); bf16* h1 = (bf16*)(F.ws + WS_H1);
    const int gw = F.vcu * NWAVES + F.wave, NGW = F.G * NWAVES;
    for (int m = gw; m < NTOK; m += NGW) {
        const int b = m / SEQ; const f32x4* xr = (const f32x4*)(x + (size_t)m * DM) + F.lane;
        f32x4 v[4]; float s = 0.f;
#pragma unroll
        for (int j = 0; j < 4; ++j) { v[j] = xr[64 * j]; s += (v[j].x * v[j].x + v[j].y * v[j].y) + (v[j].z * v[j].z + v[j].w * v[j].w); }
        const float rstd = 1.0f / sqrtf(wave_sum(s) * (1.0f / DM) + EPS);
        v2u* o = (v2u*)(h1 + (size_t)m * DM) + F.lane;
#pragma unroll
        for (int j = 0; j < 4; ++j) { const int col = 4 * (F.lane + 64 * j);
            const f32x4 gg = *(const f32x4*)(g + col), sh = *(const f32x4*)(mod + b * NMOD + col), sc = *(const f32x4*)(mod + b * NMOD + DM + col);
            o[64 * j] = pack4(v[j] * rstd * gg * (sc + 1.0f) + sh); }
    }
}
__device__ __forceinline__ void phase_dil_merge(Frame& F) {
    const bf16* dilo = (const bf16*)(F.ws + WS_DILO); const float* lse = (const float*)(F.ws + WS_LSE); bf16* dm = (bf16*)(F.ws + WS_DILM);
    const int gt = F.vcu * NWAVES * 64 + F.tid, NGT = F.G * NWAVES * 64;
    for (int it = gt; it < NTOK * 32; it += NGT) {
        const int tok = it >> 5, ch = it & 31, j = ch >> 3;
        const float l0 = lse[(size_t)tok * 4 + j], l1 = lse[(size_t)NTOK * 4 + (size_t)tok * 4 + j], l2 = lse[(size_t)2 * NTOK * 4 + (size_t)tok * 4 + j];
        const float mx = __builtin_fmaxf(l0, __builtin_fmaxf(l1, l2));
        float w0 = fexp2(l0 - mx), w1 = fexp2(l1 - mx), w2 = fexp2(l2 - mx); const float inv = 1.0f / (w0 + w1 + w2); w0 *= inv; w1 *= inv; w2 *= inv;
        const v4u a = *(const v4u*)(dilo + (size_t)tok * 256 + ch * 8), b = *(const v4u*)(dilo + (size_t)NTOK * 256 + (size_t)tok * 256 + ch * 8), c = *(const v4u*)(dilo + (size_t)2 * NTOK * 256 + (size_t)tok * 256 + ch * 8);
        v4u o;
#pragma unroll
        for (int i = 0; i < 4; ++i) { const float lo = w0 * bf_lo(a[i]) + w1 * bf_lo(b[i]) + w2 * bf_lo(c[i]), hh = w0 * bf_hi(a[i]) + w1 * bf_hi(b[i]) + w2 * bf_hi(c[i]); o[i] = cvt_pk_bf16(lo, hh); }
        *(v4u*)(dm + (size_t)tok * 256 + ch * 8) = o;
    }
}
__device__ __forceinline__ void phase_x1_h2(Frame& F) {
    const float* x = F.in[0]; const float* y = (const float*)(F.ws + WS_Y); const float* gpm = F.in[10]; const float* gpf = F.in[11];
    const float* mod = (const float*)(F.ws + WS_MOD); bf16* h2 = (bf16*)(F.ws + WS_H2);
    const int gw = F.vcu * NWAVES + F.wave, NGW = F.G * NWAVES;
    for (int m = gw; m < NTOK; m += NGW) {
        const int b = m / SEQ; const f32x4* yr = (const f32x4*)(y + (size_t)m * DM) + F.lane; const f32x4* xr = (const f32x4*)(x + (size_t)m * DM) + F.lane;
        f32x4 v[4]; float s = 0.f;
#pragma unroll
        for (int j = 0; j < 4; ++j) { v[j] = yr[64 * j]; s += (v[j].x * v[j].x + v[j].y * v[j].y) + (v[j].z * v[j].z + v[j].w * v[j].w); }
        const float rstd = 1.0f / sqrtf(wave_sum(s) * (1.0f / DM) + EPS);
        float s2 = 0.f;
#pragma unroll
        for (int j = 0; j < 4; ++j) { const int col = 4 * (F.lane + 64 * j);
            const f32x4 gg = *(const f32x4*)(gpm + col), gt = *(const f32x4*)(mod + b * NMOD + 2 * DM + col);
            v[j] = xr[64 * j] + gt * (v[j] * rstd * gg);
            s2 += (v[j].x * v[j].x + v[j].y * v[j].y) + (v[j].z * v[j].z + v[j].w * v[j].w); }
        const float rstd2 = 1.0f / sqrtf(wave_sum(s2) * (1.0f / DM) + EPS);
        f32x4* xo = (f32x4*)(F.out + (size_t)m * DM) + F.lane; v2u* o = (v2u*)(h2 + (size_t)m * DM) + F.lane;
#pragma unroll
        for (int j = 0; j < 4; ++j) { const int col = 4 * (F.lane + 64 * j);
            xo[64 * j] = v[j];
            const f32x4 gg = *(const f32x4*)(gpf + col), sh = *(const f32x4*)(mod + b * NMOD + 3 * DM + col), sc = *(const f32x4*)(mod + b * NMOD + 4 * DM + col);
            o[64 * j] = pack4(v[j] * rstd2 * gg * (sc + 1.0f) + sh); }
    }
}
__device__ __forceinline__ void phase_final(Frame& F) {
    const float* y = (const float*)(F.ws + WS_YTOT); const float* g = F.in[20]; const float* mod = (const float*)(F.ws + WS_MOD);
    const int gw = F.vcu * NWAVES + F.wave, NGW = F.G * NWAVES;
    for (int m = gw; m < NTOK; m += NGW) {
        const int b = m / SEQ; const f32x4* yr = (const f32x4*)(y + (size_t)m * DM) + F.lane; f32x4* xo = (f32x4*)(F.out + (size_t)m * DM) + F.lane;
        f32x4 v[4]; float s = 0.f;
#pragma unroll
        for (int j = 0; j < 4; ++j) { v[j] = yr[64 * j]; s += (v[j].x * v[j].x + v[j].y * v[j].y) + (v[j].z * v[j].z + v[j].w * v[j].w); }
        const float rstd = 1.0f / sqrtf(wave_sum(s) * (1.0f / DM) + EPS);
#pragma unroll
        for (int j = 0; j < 4; ++j) { const int col = 4 * (F.lane + 64 * j);
            const f32x4 gg = *(const f32x4*)(g + col), gt = *(const f32x4*)(mod + b * NMOD + 5 * DM + col);
            xo[64 * j] = xo[64 * j] + gt * (v[j] * rstd * gg); }
    }
}
__device__ __forceinline__ void phase_route(Frame& F) {
    const float* scores = (const float*)(F.ws + WS_SCORES); const float* rbias = F.in[13];
    int* tok_e = (int*)(F.ws + WS_TOKE); float* tok_w = (float*)(F.ws + WS_TOKW); unsigned* cnt = F.ctl + CW_CNT;
    const int gw = F.vcu * NWAVES + F.wave, NGW = F.G * NWAVES, lane = F.lane, half = lane >> 5;
    float rb[4];
#pragma unroll
    for (int i = 0; i < 4; ++i) rb[i] = rbias[lane + 64 * i];
    for (int tok = gw; tok < NTOK; tok += NGW) {
        float s[4], sel[4], gs[4];
#pragma unroll
        for (int i = 0; i < 4; ++i) { s[i] = scores[(size_t)tok * NE + lane + 64 * i]; sel[i] = s[i] + rb[i]; }
#pragma unroll
        for (int i = 0; i < 4; ++i) {
            float m1 = sel[i], m2 = -INFINITY;
#pragma unroll
            for (int off = 16; off >= 1; off >>= 1) { const float o1 = __shfl_xor(m1, off), o2 = __shfl_xor(m2, off);
                m2 = __builtin_fmaxf(__builtin_fminf(m1, o1), __builtin_fmaxf(m2, o2)); m1 = __builtin_fmaxf(m1, o1); }
            gs[i] = m1 + m2;
        }
        float gv[8];
#pragma unroll
        for (int i = 0; i < 4; ++i) { gv[2 * i] = __shfl(gs[i], 0); gv[2 * i + 1] = __shfl(gs[i], 32); }
        unsigned keepmask = 0u;
#pragma unroll
        for (int g = 0; g < 8; ++g) { int rank = 0;
#pragma unroll
            for (int h = 0; h < 8; ++h) rank += (gv[h] > gv[g] || (gv[h] == gv[g] && h < g)) ? 1 : 0;
            if (rank < 4) keepmask |= 1u << g; }
        float ms[4];
#pragma unroll
        for (int i = 0; i < 4; ++i) ms[i] = ((keepmask >> (2 * i + half)) & 1u) ? sel[i] : -INFINITY;
        int ek = 0; float sk = 0.f, ssum = 0.f;
        unsigned taken = 0u;
#pragma unroll 1
        for (int k = 0; k < 8; ++k) {
            float bv = -INFINITY; int bi = lane;
#pragma unroll
            for (int i = 0; i < 4; ++i) { const float v = ((taken >> i) & 1u) ? -INFINITY : ms[i]; if (v > bv) { bv = v; bi = lane + 64 * i; } }
#pragma unroll
            for (int off = 32; off >= 1; off >>= 1) { const float ov = __shfl_xor(bv, off); const int oi = __shfl_xor(bi, off);
                if (ov > bv || (ov == bv && oi < bi)) { bv = ov; bi = oi; } }
            bi = __builtin_amdgcn_readfirstlane(bi);
            const int src = bi & 63, reg = bi >> 6;
            const float cand = reg == 0 ? s[0] : reg == 1 ? s[1] : reg == 2 ? s[2] : s[3];
            const float sc = __shfl(cand, src);
            if (lane == src) taken |= 1u << reg;
            ssum += sc; if (lane == k) { ek = bi; sk = sc; }
        }
        if (lane < 8) {
            const unsigned pos = __hip_atomic_fetch_add(cnt + ek, 1u, RLX_AGENT);
            tok_e[(size_t)tok * 8 + lane] = ek * 32768 + (int)pos;
            tok_w[(size_t)tok * 8 + lane] = sk / ssum * ROUTED_SCALE;
        }
    }
}
__device__ __forceinline__ void build_tables(Frame& F) {
    LAS int* T = (LAS int*)(F.lds + TAB_TSTART); LAS int* R = (LAS int*)(F.lds + TAB_RSTART); LAS int* C = (LAS int*)(F.lds + TAB_CNT);
    __syncthreads();
    if (F.tid < NE) C[F.tid] = (int)__hip_atomic_load(F.ctl + CW_CNT + F.tid, RLX_AGENT);
    __syncthreads();
    if (F.tid == 0) { int r = 0, t = 0; for (int e = 0; e < NE; ++e) { R[e] = r; T[e] = t; const int c = C[e]; r += c; t += (c + 255) >> 8; } R[NE] = r; T[NE] = t; R[NE + 1] = r; T[NE + 1] = t + 128; }
    __syncthreads();
}
__device__ __forceinline__ void phase_compact(Frame& F) {
    build_tables(F);
    const LAS int* R = (const LAS int*)(F.lds + TAB_RSTART);
    const int* tok_e = (const int*)(F.ws + WS_TOKE); const float* tok_w = (const float*)(F.ws + WS_TOKW);
    int* slot_tok = (int*)(F.ws + WS_SLOTTOK); float* slot_w = (float*)(F.ws + WS_SLOTW); int* tok_row = (int*)(F.ws + WS_TOKROW);
    const int gt = F.vcu * NWAVES * 64 + F.tid, NGT = F.G * NWAVES * 64;
    for (int it = gt; it < NSLOTS; it += NGT) {
        const int pk = tok_e[it], e = pk >> 15, pos = pk & 32767, row = R[e] + pos;
        slot_tok[row] = it >> 3; slot_w[row] = tok_w[it]; tok_row[it] = row;
    }
}

template <bool VARK> struct DenseSchedT {
    static constexpr bool GATHER = false, VAR = VARK;
    int nM, nN, nwg, G, c, dup;
    const char* A; const char* B; int K, lda; size_t a_tile_bytes, b_tile_bytes;
    const char* A2; const char* B2; int K2, lda2; size_t a2_tile_bytes, b2_tile_bytes;
    int qs_mask_lo;
    __device__ __forceinline__ bool next(int i, pg8::Unit& u) const {
        const int ti = i / dup, kd = i - ti * dup;
        const long L = (long)ti * G + c; if (L >= nwg) return false;
        int wgid = (int)L; { const int q = nwg / 8, r = nwg % 8, xcd = wgid % 8, off = wgid / 8; wgid = (xcd < r ? xcd * (q + 1) : r * (q + 1) + (xcd - r) * q) + off; }
        const int nig = 8 * nN, gid = wgid / nig, fm = gid * 8, gsz = (nM - fm) < 8 ? (nM - fm) : 8;
        const int pm = fm + ((wgid % nig) % gsz), pn = (wgid % nig) / gsz;
        u.rows = nullptr; u.nvalid = 256; u.r0 = pm * 256; u.c0 = pn * 256; u.e = 0;
        if (kd == 0) { u.A = A + (size_t)pm * a_tile_bytes; u.B = B + (size_t)pn * b_tile_bytes; u.K = K; u.lda = lda; u.kind = (dup == 1) ? ((qs_mask_lo >> pn) & 1) : 0; }
        else { u.A = A2 + (size_t)pm * a2_tile_bytes; u.B = B2 + (size_t)pn * b2_tile_bytes; u.K = K2; u.lda = lda2; u.kind = 1; }
        return true;
    }
};
template <int MODE> struct ExpertSched {
    static constexpr bool GATHER = (MODE == 0), VAR = false;
    const LAS int* T; const LAS int* R; const LAS int* C; int G, c; const unsigned char* ws;
    __device__ __forceinline__ bool next(int i, pg8::Unit& u) const {
        constexpr int NSUB = MODE == 0 ? 2 : 4;
        const int ntile = __builtin_amdgcn_readfirstlane(MODE == 0 ? T[NE + 1] : T[NE]);
        const long L = (long)i * G + c; if (L >= (long)ntile * NSUB) return false;
        const int tile = (int)(L / NSUB), sub = (int)(L % NSUB);
        int lo = 0, hi = NE;
#pragma unroll 1
        while (lo < hi) { const int mid = (lo + hi + 1) >> 1; if (__builtin_amdgcn_readfirstlane(T[mid]) <= tile) lo = mid; else hi = mid - 1; }
        const int e = lo, mt = tile - __builtin_amdgcn_readfirstlane(T[e]);
        const int Re = __builtin_amdgcn_readfirstlane(R[e]), Ce = __builtin_amdgcn_readfirstlane(C[e < NE ? e : 0]);
        u.e = e; u.kind = sub;
        if (MODE == 0) {
            u.K = 1024; u.lda = 1024; u.c0 = 128 * sub;
            u.B = (const char*)(ws + WS_WGU) + ((size_t)e * 512 + (size_t)sub * 256) * 1024 * 2;
            if (e < NE) { u.A = (const char*)(ws + WS_H2); u.rows = (const int*)(ws + WS_SLOTTOK) + Re + 256 * mt; { const int rem_ = Ce - 256 * mt; u.nvalid = rem_ < 256 ? rem_ : 256; } u.r0 = Re + 256 * mt; }
            else { u.A = (const char*)(ws + WS_H2) + (size_t)mt * 256 * 1024 * 2; u.rows = nullptr; u.nvalid = 256; u.r0 = 256 * mt; }
        } else {
            u.K = 256; u.lda = 256; u.c0 = 256 * sub; u.rows = nullptr; { const int rem_ = Ce - 256 * mt; u.nvalid = rem_ < 256 ? rem_ : 256; } u.r0 = Re + 256 * mt;
            u.A = (const char*)(ws + WS_H) + (size_t)u.r0 * 256 * 2;
            u.B = (const char*)(ws + WS_WD) + ((size_t)e * 1024 + (size_t)sub * 256) * 256 * 2;
        }
        return true;
    }
};

using pg8::Acc; using pg8::Unit;
struct EpiProj { static constexpr bool PERM = true; bf16* O;
    __device__ __forceinline__ void operator()(const Acc& acc, const Unit& u, int wr, int wc, int fr, int fq) const {
        int lb = wr * 64 + fr, cq = wc * 32 + 8 * fq; asm volatile("" : "+v"(lb), "+v"(cq));
        const float sc = u.kind ? QSCALE : 1.0f; bf16* base = O + (size_t)(u.r0 + lb) * PW + u.c0 + cq;
#pragma unroll
        for (int ai = 0; ai < 2; ++ai)
#pragma unroll
            for (int m = 0; m < 4; ++m) { bf16* rowp = base + (size_t)(ai * 128 + m * 16) * PW;
#pragma unroll
                for (int bj = 0; bj < 2; ++bj) { const f32x4 v0 = acc[ai][bj][m][0] * sc, v1 = acc[ai][bj][m][1] * sc; v4u w; w.x = cvt_pk_bf16(v0[0], v0[1]); w.y = cvt_pk_bf16(v0[2], v0[3]); w.z = cvt_pk_bf16(v1[0], v1[1]); w.w = cvt_pk_bf16(v1[2], v1[3]);
                    *(v4u*)(rowp + bj * 128) = w; } }
    }
};
struct EpiBranch { static constexpr bool PERM = true; const bf16* proj; bf16* O;
    __device__ __forceinline__ void operator()(const Acc& acc, const Unit& u, int wr, int wc, int fr, int fq) const {
        int lb = wr * 64 + fr, cq = wc * 32 + 8 * fq; asm volatile("" : "+v"(lb), "+v"(cq));
        const int row0 = u.r0 + lb, col0 = u.c0 + cq; const int gc = u.kind ? C_GB : C_GA;
#pragma unroll
        for (int ai = 0; ai < 2; ++ai)
#pragma unroll
            for (int m = 0; m < 4; ++m) { const size_t row = (size_t)(row0 + ai * 128 + m * 16);
#pragma unroll
                for (int bj = 0; bj < 2; ++bj) { const int col = col0 + bj * 128;
                    const v4u gt = *(const v4u*)(proj + row * PW + gc + col);
                    float v[8];
#pragma unroll
                    for (int i = 0; i < 4; ++i) { v[2 * i] = sigmoidf_(bf_lo(gt[i])) * acc[ai][bj][m][i >> 1][(2 * i) & 3]; v[2 * i + 1] = sigmoidf_(bf_hi(gt[i])) * acc[ai][bj][m][i >> 1][(2 * i + 1) & 3]; }
                    bf16* op = O + row * DM + col;
                    if (u.kind) { const v4u pr = __builtin_nontemporal_load((const v4u*)op);
#pragma unroll
                        for (int i = 0; i < 4; ++i) { v[2 * i] += bf_lo(pr[i]); v[2 * i + 1] += bf_hi(pr[i]); } }
                    v4u w; w.x = cvt_pk_bf16(v[0], v[1]); w.y = cvt_pk_bf16(v[2], v[3]); w.z = cvt_pk_bf16(v[4], v[5]); w.w = cvt_pk_bf16(v[6], v[7]);
                    *(v4u*)op = w; } }
    }
};
template <bool SIG> struct EpiF32 { static constexpr bool PERM = false; float* C; int ldc;
    __device__ __forceinline__ void operator()(const Acc& acc, const Unit& u, int wr, int wc, int fr, int fq) const {
        int lb = wr * 64 + fr, cq = wc * 32 + 4 * fq; asm volatile("" : "+v"(lb), "+v"(cq));
        float* base = C + (size_t)(u.r0 + lb) * ldc + u.c0 + cq;
#pragma unroll
        for (int ai = 0; ai < 2; ++ai)
#pragma unroll
            for (int m = 0; m < 4; ++m) { float* rowp = base + (size_t)(ai * 128 + m * 16) * ldc;
#pragma unroll
                for (int bj = 0; bj < 2; ++bj)
#pragma unroll
                    for (int n = 0; n < 2; ++n) { f32x4 v = acc[ai][bj][m][n]; if (SIG) { v.x = sigmoidf_(v.x); v.y = sigmoidf_(v.y); v.z = sigmoidf_(v.z); v.w = sigmoidf_(v.w); }
                        *(f32x4*)(rowp + bj * 128 + n * 16) = v; } }
    }
};
struct EpiUp { static constexpr bool PERM = true; bf16* H; bf16* Hs;
    __device__ __forceinline__ void operator()(const Acc& acc, const Unit& u, int wr, int wc, int fr, int fq) const {
        int lb = wr * 64 + fr, cq = wc * 32 + 8 * fq; asm volatile("" : "+v"(lb), "+v"(cq));
        bf16* base = (u.e < NE ? H : Hs) + (size_t)(u.r0 + lb) * EDIM + u.c0 + cq;
#pragma unroll
        for (int ai = 0; ai < 2; ++ai)
#pragma unroll
            for (int m = 0; m < 4; ++m) { const int rc = ai * 128 + m * 16;
                float v[8];
#pragma unroll
                for (int n = 0; n < 2; ++n)
#pragma unroll
                    for (int i = 0; i < 4; ++i) { const float g = acc[ai][0][m][n][i], up = acc[ai][1][m][n][i]; v[4 * n + i] = g * sigmoidf_(g) * up; }
                v4u w; w.x = cvt_pk_bf16(v[0], v[1]); w.y = cvt_pk_bf16(v[2], v[3]); w.z = cvt_pk_bf16(v[4], v[5]); w.w = cvt_pk_bf16(v[6], v[7]);
                if (lb < u.nvalid - rc) *(v4u*)(base + (size_t)rc * EDIM) = w;
                asm volatile("" ::: "memory"); }
    }
};
struct EpiDown { static constexpr bool PERM = true; bf16* Y; const float* slot_w;
    __device__ __forceinline__ void operator()(const Acc& acc, const Unit& u, int wr, int wc, int fr, int fq) const {
        int lb = wr * 64 + fr, cq = wc * 32 + 8 * fq; asm volatile("" : "+v"(lb), "+v"(cq));
        bf16* base = Y + (size_t)(u.r0 + lb) * DM + u.c0 + cq; const float* swp = slot_w + u.r0 + lb;
#pragma unroll
        for (int ai = 0; ai < 2; ++ai)
#pragma unroll
            for (int m = 0; m < 4; ++m) { const int rc = ai * 128 + m * 16;
                if (lb < u.nvalid - rc) { const float sw = swp[rc];
#pragma unroll
                    for (int bj = 0; bj < 2; ++bj) { const f32x4 v0 = acc[ai][bj][m][0] * sw, v1 = acc[ai][bj][m][1] * sw; v4u w; w.x = cvt_pk_bf16(v0[0], v0[1]); w.y = cvt_pk_bf16(v0[2], v0[3]); w.z = cvt_pk_bf16(v1[0], v1[1]); w.w = cvt_pk_bf16(v1[2], v1[3]);
                        *(v4u*)(base + (size_t)rc * DM + bj * 128) = w; } }
                asm volatile("" ::: "memory"); }
    }
};
struct EpiCombine { static constexpr bool PERM = true; const bf16* Y; const int* tok_row; float* ytot;
    __device__ __forceinline__ void operator()(const Acc& acc, const Unit& u, int wr, int wc, int fr, int fq) const {
        int lb = wr * 64 + fr, cq = wc * 32 + 8 * fq; asm volatile("" : "+v"(lb), "+v"(cq));
        const int col0 = u.c0 + cq;
#pragma unroll
        for (int ai = 0; ai < 2; ++ai)
#pragma unroll
            for (int m = 0; m < 4; ++m) { const int tok = u.r0 + ai * 128 + m * 16 + lb;
                const int4 ra = *(const int4*)(tok_row + (size_t)tok * 8), rb = *(const int4*)(tok_row + (size_t)tok * 8 + 4);
                const int rr[8] = {ra.x, ra.y, ra.z, ra.w, rb.x, rb.y, rb.z, rb.w};
#pragma unroll
                for (int bj = 0; bj < 2; ++bj) { float v[8];
#pragma unroll
                    for (int i = 0; i < 4; ++i) { v[i] = acc[ai][bj][m][0][i]; v[4 + i] = acc[ai][bj][m][1][i]; }
#pragma unroll
                    for (int k = 0; k < 8; ++k) { const v4u yv = *(const v4u*)(Y + (size_t)rr[k] * DM + col0 + bj * 128);
#pragma unroll
                        for (int i = 0; i < 4; ++i) { v[2 * i] += bf_lo(yv[i]); v[2 * i + 1] += bf_hi(yv[i]); } }
                    float* op = ytot + (size_t)tok * DM + col0 + bj * 128;
                    *(f32x4*)op = (f32x4){v[0], v[1], v[2], v[3]}; *(f32x4*)(op + 4) = (f32x4){v[4], v[5], v[6], v[7]}; } }
    }
};
#ifndef MK_N_LAUNCHES
#define MK_N_LAUNCHES 1
#endif
constexpr int N_PHASES = 15;
constexpr int N_LAUNCHES = MK_N_LAUNCHES;
static_assert(N_LAUNCHES == 1 || N_LAUNCHES == N_PHASES, "MK_N_LAUNCHES is 1 or N_PHASES");

struct Args { const float* in[21]; float* out; unsigned char* ws; int ph_lo, ph_hi; };
static_assert(sizeof(Args) == 21 * 8 + 8 + 8 + 8, "Args has no padding");

__global__ void __launch_bounds__(NWAVES * 64, 2) fwd_kernel(Args args) {
    extern __shared__ __attribute__((aligned(16))) unsigned char lds[];
    Frame F;
    F.lds = (LAS unsigned char*)lds;
    F.MISC = (volatile LAS unsigned*)(F.lds + MISC_OFF);
    F.tid = threadIdx.x; F.lane = F.tid & 63; F.wave = __builtin_amdgcn_readfirstlane(F.tid >> 6);
    F.G = gridDim.x; { const int bx = blockIdx.x; F.vcu = (F.G % 8 == 0) ? (bx % 8) * (F.G / 8) + bx / 8 : bx; }
    F.ws = args.ws; F.ctl = (unsigned*)(args.ws + WS_CTL); F.out = args.out;
#pragma unroll
    for (int i = 0; i < 21; ++i) F.in[i] = args.in[i];
    for (int u = F.tid; u < (LDS_BYTES - LDSCTL_OFF) / 4; u += NWAVES * 64) ((LAS unsigned*)(F.lds + LDSCTL_OFF))[u] = 0u;
    __syncthreads();
    XcdBarrier bar; bar.bar = F.ctl + CW_BAR; bar.x = 0; bar.st = nullptr;
    if (N_LAUNCHES == 1) bar = xcd_barrier_post(F.ctl + CW_BAR, F.MISC + 8);
#define GRID_BAR() do { if (N_LAUNCHES == 1) xcd_barrier(bar); } while (0)
    const int lo = args.ph_lo, hi = args.ph_hi;
#ifdef ONLY_PHASE
#define IN(k) ((k) == ONLY_PHASE && lo <= (k) && (k) < hi)
#else
#define IN(k) (lo <= (k) && (k) < hi)
#endif
#define SEAM(k) do { if (IN(k) && IN((k) + 1)) GRID_BAR(); } while (0)
    unsigned char* ws = args.ws;

    if (IN(0)) { phase_mod_smallw(F); } SEAM(0);
    if (IN(1)) { phase_h1(F); } SEAM(1);
    if (IN(2)) {
        DenseSchedT<false> S{}; S.nM = NTOK / 256; S.nN = PW / 256; S.nwg = S.nM * S.nN; S.G = F.G; S.c = (int)blockIdx.x; S.dup = 1;
        S.A = (const char*)(ws + WS_H1); S.B = (const char*)(ws + WS_WIN); S.K = DM; S.lda = DM; S.a_tile_bytes = (size_t)256 * DM * 2; S.b_tile_bytes = (size_t)256 * DM * 2;
        S.qs_mask_lo = 0x3 | (0x7 << 6);
        EpiProj E{(bf16*)(ws + WS_PROJ)};
        pg8::gemm_phase<EpiProj, DenseSchedT<false>, true>(F.lds, S, E);
    } SEAM(2);
    if (IN(3)) {
        const bf16* proj = (const bf16*)(ws + WS_PROJ);
        for (int i = 0;; ++i) {
            const int L = i * F.G + F.vcu; if (L >= 2560) break;
            if (L < 1024) { const int bh = L >> 4, qb = L & 15; att::sb_unit(bh >> 3, bh & 7, qb, proj, (bf16*)(ws + WS_SBO), (char*)lds); }
            else { const int d = L - 1024, bgj = d >> 4, sub = d & 15, b = bgj / 12, gj = bgj % 12, g = gj >> 2, j = gj & 3;
                   const int c = (g == 0) ? 0 : (g == 1) ? (sub >> 2) : sub, qblk = (g == 0) ? sub : (g == 1) ? (sub & 3) : 0;
                   att::dil_unit(b, g, c, j, qblk, proj, F.in[2], (bf16*)(ws + WS_DILO), (float*)(ws + WS_LSE), (char*)lds); }
        }
    } SEAM(3);
    if (IN(4)) { phase_dil_merge(F); } SEAM(4);
    if (IN(5)) {
        DenseSchedT<true> S{}; S.nM = NTOK / 256; S.nN = DM / 256; S.nwg = S.nM * S.nN; S.G = F.G; S.c = (int)blockIdx.x; S.dup = 2;
        S.A = (const char*)(ws + WS_SBO); S.B = (const char*)(ws + WS_WBA); S.K = 512; S.lda = 512; S.a_tile_bytes = (size_t)256 * 512 * 2; S.b_tile_bytes = (size_t)256 * 512 * 2;
        S.A2 = (const char*)(ws + WS_DILM); S.B2 = (const char*)(ws + WS_WBB); S.K2 = 256; S.lda2 = 256; S.a2_tile_bytes = (size_t)256 * 256 * 2; S.b2_tile_bytes = (size_t)256 * 256 * 2;
        EpiBranch E{(const bf16*)(ws + WS_PROJ), (bf16*)(ws + WS_MERGED)};
        pg8::gemm_phase<EpiBranch, DenseSchedT<true>, true>(F.lds, S, E);
    } SEAM(5);
    if (IN(6)) {
        DenseSchedT<false> S{}; S.nM = NTOK / 256; S.nN = DM / 256; S.nwg = S.nM * S.nN; S.G = F.G; S.c = (int)blockIdx.x; S.dup = 1;
        S.A = (const char*)(ws + WS_MERGED); S.B = (const char*)(ws + WS_WOUT); S.K = DM; S.lda = DM; S.a_tile_bytes = (size_t)256 * DM * 2; S.b_tile_bytes = (size_t)256 * DM * 2;
        EpiF32<false> E{(float*)(ws + WS_Y), DM};
        pg8::gemm_phase<EpiF32<false>, DenseSchedT<false>, true>(F.lds, S, E);
    } SEAM(6);
    if (IN(7)) { phase_x1_h2(F); } SEAM(7);
    if (IN(8)) {
        DenseSchedT<false> S{}; S.nM = NTOK / 256; S.nN = 1; S.nwg = S.nM; S.G = F.G; S.c = (int)blockIdx.x; S.dup = 1;
        S.A = (const char*)(ws + WS_H2); S.B = (const char*)(ws + WS_WR); S.K = DM; S.lda = DM; S.a_tile_bytes = (size_t)256 * DM * 2; S.b_tile_bytes = (size_t)256 * DM * 2;
        EpiF32<true> E{(float*)(ws + WS_SCORES), NE};
        pg8::gemm_phase<EpiF32<true>, DenseSchedT<false>, true>(F.lds, S, E);
        __syncthreads();
        phase_expert_weights(F);
    } SEAM(8);
    if (IN(9)) { phase_route(F); } SEAM(9);
    if (IN(10)) { phase_compact(F); } SEAM(10);
    if (IN(11)) {
        build_tables(F);
        ExpertSched<0> S{(const LAS int*)(F.lds + TAB_TSTART), (const LAS int*)(F.lds + TAB_RSTART), (const LAS int*)(F.lds + TAB_CNT), F.G, F.vcu, ws};
        EpiUp E{(bf16*)(ws + WS_H), (bf16*)(ws + WS_HS)};
        pg8::gemm_phase<EpiUp, ExpertSched<0>, true>(F.lds, S, E);
    } SEAM(11);
    if (IN(12)) {
        build_tables(F);
        ExpertSched<1> S{(const LAS int*)(F.lds + TAB_TSTART), (const LAS int*)(F.lds + TAB_RSTART), (const LAS int*)(F.lds + TAB_CNT), F.G, F.vcu, ws};
        EpiDown E{(bf16*)(ws + WS_YS), (const float*)(ws + WS_SLOTW)};
        pg8::gemm_phase<EpiDown, ExpertSched<1>, true>(F.lds, S, E);
    } SEAM(12);
    if (IN(13)) {
        DenseSchedT<false> S{}; S.nM = NTOK / 256; S.nN = DM / 256; S.nwg = S.nM * S.nN; S.G = F.G; S.c = (int)blockIdx.x; S.dup = 1;
        S.A = (const char*)(ws + WS_HS); S.B = (const char*)(ws + WS_WD) + (size_t)NE * 1024 * 256 * 2; S.K = 256; S.lda = 256; S.a_tile_bytes = (size_t)256 * 256 * 2; S.b_tile_bytes = (size_t)256 * 256 * 2;
        EpiCombine E{(const bf16*)(ws + WS_YS), (const int*)(ws + WS_TOKROW), (float*)(ws + WS_YTOT)};
        pg8::gemm_phase<EpiCombine, DenseSchedT<false>, true>(F.lds, S, E);
    } SEAM(13);
    if (IN(14)) { phase_final(F); }
#undef IN
#undef SEAM
#undef GRID_BAR
}

#ifdef MK_CHECK
constexpr size_t WS_FAIL = 12 * MiB;
__device__ __forceinline__ float bf2f(bf16 v) { return __uint_as_float((unsigned)v << 16); }
__device__ __forceinline__ unsigned hsh(unsigned x) { x ^= x >> 16; x *= 0x7feb352dU; x ^= x >> 15; x *= 0x846ca68bU; x ^= x >> 16; return x; }
__device__ __forceinline__ bool close_(float a, float ref, float scale) { const float d = fabsf(a - ref); return d <= 0.03f * fabsf(ref) + 0.03f * scale && !(a != a); }
__device__ __forceinline__ float silu_(float v) { return v / (1.0f + expf(-v)); }
__device__ __forceinline__ float sig_(float v) { return 1.0f / (1.0f + expf(-v)); }

__global__ void check_kernel(Args args, int phase) {
    unsigned char* ws = args.ws; unsigned* failw = (unsigned*)(ws + WS_FAIL);
    const int gt = blockIdx.x * blockDim.x + threadIdx.x; const unsigned h0 = hsh(gt * 2654435761u + phase * 97u + 12345u);
    const float* mod = (const float*)(ws + WS_MOD);
    bool ok = true;
    const bf16* proj = (const bf16*)(ws + WS_PROJ);
    if (phase == 0) {
        const int b = h0 % 8, n = (h0 >> 3) % NMOD; float s = args.in[4][n];
        for (int k = 0; k < DM; ++k) s += silu_(args.in[1][b * DM + k]) * args.in[3][(size_t)k * NMOD + n];
        ok = close_(mod[b * NMOD + n], s, 0.3f);
        const int k = (h0 >> 8) % DM, c = (h0 >> 18) % PW;
        ok = ok && close_(bf2f(((const bf16*)(ws + WS_WIN))[(size_t)c * DM + k]), args.in[6][(size_t)k * PW + c], 0.03f);
        const int k2 = (h0 >> 5) % 512, c2 = (h0 >> 14) % DM;
        ok = ok && close_(bf2f(((const bf16*)(ws + WS_WBA))[(size_t)c2 * 512 + k2]), args.in[7][(size_t)k2 * DM + c2], 0.03f);
        ok = ok && close_(bf2f(((const bf16*)(ws + WS_WBB))[(size_t)c2 * 256 + (k2 & 255)]), args.in[8][(size_t)(k2 & 255) * DM + c2], 0.03f);
        ok = ok && close_(bf2f(((const bf16*)(ws + WS_WOUT))[(size_t)c2 * DM + k]), args.in[9][(size_t)k * DM + c2], 0.03f);
        ok = ok && close_(bf2f(((const bf16*)(ws + WS_WR))[(size_t)(c2 & 255) * DM + k]), args.in[12][(size_t)k * NE + (c2 & 255)], 0.03f);
    } else if (phase == 1) {
        const int tok = h0 % NTOK, col = (h0 >> 15) % DM, b = tok / SEQ; const float* xr = args.in[0] + (size_t)tok * DM; float ss = 0.f;
        for (int k = 0; k < DM; ++k) ss += xr[k] * xr[k];
        const float v = xr[col] * rsqrtf(ss / DM + EPS) * args.in[5][col] * (1.f + mod[b * NMOD + DM + col]) + mod[b * NMOD + col];
        ok = close_(bf2f(((const bf16*)(ws + WS_H1))[(size_t)tok * DM + col]), v, 1.0f);
    } else if (phase == 2) {
        const int tok = h0 % NTOK, col = (h0 >> 15) % PW; const bf16* hr = (const bf16*)(ws + WS_H1) + (size_t)tok * DM; float s = 0.f;
        for (int k = 0; k < DM; ++k) s += bf2f(hr[k]) * args.in[6][(size_t)k * PW + col];
        if (col < 512 || (col >= 1536 && col < 2304)) s *= QSCALE;
        ok = close_(bf2f(proj[(size_t)tok * PW + col]), s, 1.0f);
    } else if (phase == 3) {
        if (gt < 512) {
            const int b = h0 % 8, h = (h0 >> 3) % 8, t = (gt < 32) ? gt : (h0 >> 6) % SEQ, dd = (h0 >> 20) % 64; const bf16* q = proj + ((size_t)b * SEQ + t) * PW + h * 64;
            float o = 0.f, L = 0.f;
            for (int s = t - 1; s >= 0 && L > -200.f; --s) { const bf16* kr = proj + ((size_t)b * SEQ + s) * PW + 512 + h * 64; const bf16* vr = kr + 512; float z = 0.f;
                for (int d = 0; d < 64; ++d) z += bf2f(q[d]) * bf2f(kr[d]);
                z *= 0.6931471805599453f;
                const float sp = (z > 0.f ? z : 0.f) + log1pf(expf(-fabsf(z))); const float w = expf(z - sp + L); L -= sp;
                o += w * bf2f(vr[dd]); }
            const bf16* so = (const bf16*)(ws + WS_SBO) + ((size_t)b * SEQ + t) * 512 + h * 64;
            ok = close_(bf2f(so[dd]), o, 0.05f);
        } else if (gt < 1024) {
            const int b = h0 % 8, g = (h0 >> 3) % 3, j = (h0 >> 5) % 4, t = (gt < 544) ? (gt - 512) * 3 : (h0 >> 7) % SEQ, r = g == 0 ? 1 : g == 1 ? 4 : 16, dd = (h0 >> 20) % 64; const int hd = (g * 4 + j) * 64;
            const bf16* q = proj + ((size_t)b * SEQ + t) * PW + 1536 + hd; float o = 0.f, m = -1e30f, l = 0.f;
            for (int i = 0; i <= 128; ++i) { const int s = t - i * r; if (s < 0) break; const bf16* kr = proj + ((size_t)b * SEQ + s) * PW + 2304 + hd; const bf16* vr = kr + 768; float z = 0.f;
                for (int d = 0; d < 64; ++d) z += bf2f(q[d]) * bf2f(kr[d]);
                const int dist = i * r; int bk = dist; if (dist >= 16) { bk = 16 + (int)(logf((float)dist / 16.f) / 4.852030263919617f * 16.f); if (bk > 31) bk = 31; }
                z = z * 0.6931471805599453f + args.in[2][bk * 12 + g * 4 + j];
                const float mn = fmaxf(m, z), a = expf(m - mn), p = expf(z - mn); l = l * a + p; o = o * a + p * bf2f(vr[dd]); m = mn; }
            const bf16* so = (const bf16*)(ws + WS_DILO) + (size_t)g * NTOK * 256 + ((size_t)b * SEQ + t) * 256 + j * 64;
            ok = close_(bf2f(so[dd]), o / l, 0.05f);
            const float lse2 = ((const float*)(ws + WS_LSE))[(size_t)g * NTOK * 4 + ((size_t)b * SEQ + t) * 4 + j];
            ok = ok && close_(lse2 * 0.6931471805599453f, m + logf(l), 0.1f);
        }
    } else if (phase == 4) {
        const int tok = h0 % NTOK, col = (h0 >> 15) % 256, j = col >> 6; const float* lse = (const float*)(ws + WS_LSE); float w[3], mx = -1e30f, sm = 0.f, v = 0.f;
#pragma unroll
        for (int g = 0; g < 3; ++g) { w[g] = lse[(size_t)g * NTOK * 4 + (size_t)tok * 4 + j] * 0.6931471805599453f; mx = fmaxf(mx, w[g]); }
#pragma unroll
        for (int g = 0; g < 3; ++g) { w[g] = expf(w[g] - mx); sm += w[g]; }
#pragma unroll
        for (int g = 0; g < 3; ++g) v += w[g] / sm * bf2f(((const bf16*)(ws + WS_DILO))[(size_t)g * NTOK * 256 + (size_t)tok * 256 + col]);
        ok = close_(bf2f(((const bf16*)(ws + WS_DILM))[(size_t)tok * 256 + col]), v, 0.3f);
    } else if (phase == 5) {
        const int tok = h0 % NTOK, col = (h0 >> 15) % DM; float a = 0.f, b2 = 0.f;
        for (int k = 0; k < 512; ++k) a += bf2f(((const bf16*)(ws + WS_SBO))[(size_t)tok * 512 + k]) * args.in[7][(size_t)k * DM + col];
        for (int k = 0; k < 256; ++k) b2 += bf2f(((const bf16*)(ws + WS_DILM))[(size_t)tok * 256 + k]) * args.in[8][(size_t)k * DM + col];
        const float v = sig_(bf2f(proj[(size_t)tok * PW + C_GA + col])) * a + sig_(bf2f(proj[(size_t)tok * PW + C_GB + col])) * b2;
        ok = close_(bf2f(((const bf16*)(ws + WS_MERGED))[(size_t)tok * DM + col]), v, 0.2f);
    } else if (phase == 6) {
        const int tok = h0 % NTOK, col = (h0 >> 15) % DM; float s = 0.f;
        for (int k = 0; k < DM; ++k) s += bf2f(((const bf16*)(ws + WS_MERGED))[(size_t)tok * DM + k]) * args.in[9][(size_t)k * DM + col];
        ok = close_(((const float*)(ws + WS_Y))[(size_t)tok * DM + col], s, 0.2f);
    } else if (phase == 7) {
        const int tok = h0 % NTOK, col = (h0 >> 15) % DM, b = tok / SEQ; const float* yr = (const float*)(ws + WS_Y) + (size_t)tok * DM; float ss = 0.f, s2 = 0.f;
        for (int k = 0; k < DM; ++k) ss += yr[k] * yr[k];
        const float rs = rsqrtf(ss / DM + EPS);
        for (int k = 0; k < DM; ++k) { const float x1 = args.in[0][(size_t)tok * DM + k] + mod[b * NMOD + 2 * DM + k] * (yr[k] * rs * args.in[10][k]); s2 += x1 * x1; }
        const float x1c = args.in[0][(size_t)tok * DM + col] + mod[b * NMOD + 2 * DM + col] * (yr[col] * rs * args.in[10][col]);
        ok = close_(args.out[(size_t)tok * DM + col], x1c, 1.0f);
        const float h2 = x1c * rsqrtf(s2 / DM + EPS) * args.in[11][col] * (1.f + mod[b * NMOD + 4 * DM + col]) + mod[b * NMOD + 3 * DM + col];
        ok = ok && close_(bf2f(((const bf16*)(ws + WS_H2))[(size_t)tok * DM + col]), h2, 1.0f);
    } else if (phase == 8) {
        const int tok = h0 % NTOK, e = (h0 >> 15) % NE; float s = 0.f;
        for (int k = 0; k < DM; ++k) s += bf2f(((const bf16*)(ws + WS_H2))[(size_t)tok * DM + k]) * args.in[12][(size_t)k * NE + e];
        ok = close_(((const float*)(ws + WS_SCORES))[(size_t)tok * NE + e], sig_(s), 0.2f);
        const int ee = (h0 >> 4) % 257, k = (h0 >> 13) % DM, n = (h0 >> 23) % EDIM;
        const float wg = ee < NE ? args.in[14][((size_t)ee * DM + k) * EDIM + n] : args.in[17][(size_t)k * EDIM + n], wu = ee < NE ? args.in[15][((size_t)ee * DM + k) * EDIM + n] : args.in[18][(size_t)k * EDIM + n];
        const float wd = ee < NE ? args.in[16][((size_t)ee * EDIM + n) * DM + k] : args.in[19][(size_t)n * DM + k];
        const bf16* WG = (const bf16*)(ws + WS_WGU) + ((size_t)ee * 512 + (size_t)(n >> 7) * 256 + (n & 127)) * 1024 + k;
        ok = ok && close_(bf2f(WG[0]), wg, 0.03f) && close_(bf2f(WG[128 * 1024]), wu, 0.03f);
        ok = ok && close_(bf2f(((const bf16*)(ws + WS_WD))[((size_t)ee * 1024 + k) * 256 + n]), wd, 0.06f);
    } else if (phase == 9) {
        const int tok = h0 % NTOK; const float* sc = (const float*)(ws + WS_SCORES) + (size_t)tok * NE; float gs[8]; unsigned keep = 0u;
#pragma unroll
        for (int g = 0; g < 8; ++g) { float m1 = -1e30f, m2 = -1e30f; for (int i = 0; i < 32; ++i) { const float v = sc[g * 32 + i] + args.in[13][g * 32 + i]; if (v > m1) { m2 = m1; m1 = v; } else if (v > m2) m2 = v; } gs[g] = m1 + m2; }
#pragma unroll
        for (int g = 0; g < 8; ++g) { int rk = 0;
#pragma unroll
            for (int h = 0; h < 8; ++h) rk += (gs[h] > gs[g] || (gs[h] == gs[g] && h < g)); if (rk < 4) keep |= 1u << g; }
        float ssum = 0.f; int es[8];
#pragma unroll
        for (int k = 0; k < 8; ++k) es[k] = -1;
#pragma unroll
        for (int k = 0; k < 8; ++k) { float bv = -1e30f; int bi = -1;
            for (int e = 0; e < NE; ++e) { if (!((keep >> (e >> 5)) & 1u)) continue; bool us = false;
#pragma unroll
                for (int q = 0; q < 8; ++q) us = us || es[q] == e;
                if (us) continue; const float v = sc[e] + args.in[13][e]; if (v > bv) { bv = v; bi = e; } }
            es[k] = bi; ssum += sc[bi]; }
        const int* te = (const int*)(ws + WS_TOKE) + (size_t)tok * 8; const float* tw = (const float*)(ws + WS_TOKW) + (size_t)tok * 8;
        for (int k = 0; k < 8; ++k) { const int e = te[k] >> 15; bool found = false;
#pragma unroll
            for (int q = 0; q < 8; ++q) found = found || es[q] == e;
            if (!found) atomicMin(failw, 9u);
            if (!close_(tw[k], sc[e] / ssum * ROUTED_SCALE, 0.01f)) { atomicMin(failw, 15u); atomicMax(failw + 1, __float_as_uint(fabsf(tw[k] / (sc[e] / ssum * ROUTED_SCALE)))); }
            if (!((unsigned)(te[k] & 32767) < ((const unsigned*)(ws + WS_CTL))[CW_CNT + e])) atomicMin(failw, 16u); }
        { bool dup = false; float ks = 0.f;
          for (int k = 0; k < 8; ++k) { ks += sc[te[k] >> 15]; for (int q = 0; q < k; ++q) dup = dup || ((te[k] >> 15) == (te[q] >> 15)); }
          if (dup) atomicMin(failw, 12u);
          if (fabsf(ks - ssum) > 1e-3f) atomicMin(failw, 13u);
          float tws = 0.f; for (int k = 0; k < 8; ++k) tws += tw[k];
          if (fabsf(tws - 2.5f) > 1e-2f) atomicMin(failw, 14u); }
        if (gt == 0) { unsigned tot = 0; for (int e = 0; e < NE; ++e) tot += ((const unsigned*)(ws + WS_CTL))[CW_CNT + e]; if (tot != (unsigned)NSLOTS) atomicMin(failw, 17u); }
    } else if (phase == 10) {
        const int it = h0 % NSLOTS; const int row = ((const int*)(ws + WS_TOKROW))[it];
        ok = (unsigned)row < (unsigned)NSLOTS && ((const int*)(ws + WS_SLOTTOK))[row] == (it >> 3) && ((const float*)(ws + WS_SLOTW))[row] == ((const float*)(ws + WS_TOKW))[it];
    } else if (phase == 11) {
        const int it = h0 % NSLOTS, tok = it >> 3, col = (h0 >> 18) % EDIM; const int e = ((const int*)(ws + WS_TOKE))[it] >> 15, row = ((const int*)(ws + WS_TOKROW))[it];
        const bf16* hr = (const bf16*)(ws + WS_H2) + (size_t)tok * DM; float g = 0.f, u = 0.f, g2 = 0.f, u2 = 0.f;
        for (int k = 0; k < DM; ++k) { const float hv = bf2f(hr[k]); g += hv * args.in[14][((size_t)e * DM + k) * EDIM + col]; u += hv * args.in[15][((size_t)e * DM + k) * EDIM + col]; g2 += hv * args.in[17][(size_t)k * EDIM + col]; u2 += hv * args.in[18][(size_t)k * EDIM + col]; }
        ok = close_(bf2f(((const bf16*)(ws + WS_H))[(size_t)row * EDIM + col]), silu_(g) * u, 0.3f);
        ok = ok && close_(bf2f(((const bf16*)(ws + WS_HS))[(size_t)tok * EDIM + col]), silu_(g2) * u2, 0.3f);
    } else if (phase == 12) {
        const int it = h0 % NSLOTS, col = (h0 >> 18) % DM; const int e = ((const int*)(ws + WS_TOKE))[it] >> 15, row = ((const int*)(ws + WS_TOKROW))[it]; float s = 0.f;
        for (int k = 0; k < EDIM; ++k) s += bf2f(((const bf16*)(ws + WS_H))[(size_t)row * EDIM + k]) * args.in[16][((size_t)e * EDIM + k) * DM + col];
        ok = close_(bf2f(((const bf16*)(ws + WS_YS))[(size_t)row * DM + col]), s * ((const float*)(ws + WS_TOKW))[it], 0.2f);
    } else if (phase == 13) {
        const int tok = h0 % NTOK, col = (h0 >> 15) % DM; float s = 0.f;
        for (int k = 0; k < EDIM; ++k) s += bf2f(((const bf16*)(ws + WS_HS))[(size_t)tok * EDIM + k]) * args.in[19][(size_t)k * DM + col];
        for (int k = 0; k < 8; ++k) s += bf2f(((const bf16*)(ws + WS_YS))[(size_t)((const int*)(ws + WS_TOKROW))[tok * 8 + k] * DM + col]);
        ok = close_(((const float*)(ws + WS_YTOT))[(size_t)tok * DM + col], s, 0.3f);
    }
    if (!ok) atomicMin(failw, (unsigned)phase);
}
__global__ void check_init(Args args) { if (threadIdx.x == 0) { *(unsigned*)(args.ws + WS_FAIL) = 99u; ((unsigned*)(args.ws + WS_FAIL))[1] = 0u; } }
__global__ void check_report(Args args) { const unsigned f = *(unsigned*)(args.ws + WS_FAIL); if (threadIdx.x == 0 && f != 99u) args.out[0] = 1024.0f * (float)(1u << f);
}
#endif
extern "C" void kernel_launch(void* const* d_in, const int* in_sizes, int n_in, void* d_out, int out_size, void* d_ws, size_t ws_size, hipStream_t stream) {
    static int grid = 0;
    if (grid == 0) {
        if (n_in != 21 || in_sizes[0] != NTOK * DM || out_size != NTOK * DM || ws_size < WS_END) {
            fprintf(stderr, "kernel_launch: unexpected problem (n_in %d, in0 %d, out %d, ws %zu; need ws >= %zu); nothing launched\n", n_in, n_in > 0 ? in_sizes[0] : -1, out_size, ws_size, (size_t)WS_END); grid = -1; return; }
        int dev = 0, cus = 0, per_cu = 0;
        if (hipGetDevice(&dev) != hipSuccess || hipDeviceGetAttribute(&cus, hipDeviceAttributeMultiprocessorCount, dev) != hipSuccess) { fprintf(stderr, "kernel_launch: device query failed\n"); grid = -1; return; }
        if (hipFuncSetAttribute((const void*)fwd_kernel, hipFuncAttributeMaxDynamicSharedMemorySize, LDS_BYTES) != hipSuccess) { fprintf(stderr, "kernel_launch: hipFuncSetAttribute failed\n"); grid = -1; return; }
        if (hipOccupancyMaxActiveBlocksPerMultiprocessor(&per_cu, (const void*)fwd_kernel, NWAVES * 64, LDS_BYTES) != hipSuccess || per_cu < 1)
            fprintf(stderr, "kernel_launch: note: occupancy query reports %d workgroups per CU\n", per_cu);
        (void)hipGetLastError();
        grid = cus;
    }
    if (grid < 0) return;
    if (hipMemsetAsync((char*)d_ws + WS_CTL, 0, CTL_ZERO_BYTES, stream) != hipSuccess) { fprintf(stderr, "kernel_launch: memset failed\n"); return; }
    Args a{};
    for (int i = 0; i < 21; ++i) a.in[i] = (const float*)d_in[i];
    a.out = (float*)d_out; a.ws = (unsigned char*)d_ws;
#ifdef MK_CHECK
    hipLaunchKernelGGL(check_init, dim3(1), dim3(64), 0, stream, a);
#endif
    for (int li = 0; li < N_LAUNCHES; ++li) {
        a.ph_lo = (N_LAUNCHES == 1) ? 0 : li; a.ph_hi = (N_LAUNCHES == 1) ? N_PHASES : li + 1;
        hipLaunchKernelGGL(fwd_kernel, dim3(grid), dim3(NWAVES * 64), LDS_BYTES, stream, a);
#ifdef MK_CHECK
        if (N_LAUNCHES == N_PHASES) hipLaunchKernelGGL(check_kernel, dim3(16), dim3(64), 0, stream, a, li);
#endif
        const hipError_t le = hipPeekAtLastError();
        if (le != hipSuccess) { fprintf(stderr, "kernel_launch: launch %d failed: %s\n", li, hipGetErrorName(le)); break; }
    }
#ifdef MK_CHECK
    hipLaunchKernelGGL(check_report, dim3(1), dim3(64), 0, stream, a);
#endif
}
```
